# Optimizing an MI355X kernel written in HIP

```python
import jax, jax.numpy as jnp
from jax import lax
import numpy as np

D_MODEL = 2048
BATCH = 1
SEQ = 8192
DEPTH = 1
DEC_BATCH = 4
DEC_SEQ = 2048
PAST_LEN = 128

HEAD_DIM = 128
N_HEADS_A = 8
N_KV_A = 2
N_HEADS_B = 8
D_A = N_HEADS_A * HEAD_DIM
D_KV_A = N_KV_A * HEAD_DIM
D_B = N_HEADS_B * HEAD_DIM
D_MIX = D_A + D_B
D_IN = D_A + 2 * D_KV_A + D_A + 4 * D_B
N_META = 16
GRID_W = 64
WIN_R_MAX = 8
WIN_C = 16
Q_BLOCK = 128
ROPE_THETA = 10000.0
EPS = 1e-6

kernel_name = "hymba_gqa_natten_encoder"


def rms_norm(x, w):
    xf = x.astype(jnp.float32)
    y = xf * lax.rsqrt(jnp.mean(xf * xf, axis=-1, keepdims=True) + EPS)
    return (y * w.astype(jnp.float32)).astype(x.dtype)


def split_points():
    sizes = [D_A, D_KV_A, D_KV_A, D_A, D_B, D_B, D_B, D_B]
    pts, acc = [], 0
    for s in sizes[:-1]:
        acc += s
        pts.append(acc)
    return pts


def axial_rope_tables(n_tok):
    t = jnp.arange(n_tok, dtype=jnp.int32)
    row = jnp.concatenate([jnp.full((N_META,), -1, jnp.int32), t // GRID_W]).astype(jnp.float32)
    col = jnp.concatenate([jnp.arange(N_META, dtype=jnp.int32), t % GRID_W]).astype(jnp.float32)
    half = HEAD_DIM // 2
    inv_freq = ROPE_THETA ** (-jnp.arange(0, half, 2, dtype=jnp.float32) / half)
    ang_r = row[:, None] * inv_freq[None, :]
    ang_c = col[:, None] * inv_freq[None, :]
    return (jnp.cos(ang_r), jnp.sin(ang_r), jnp.cos(ang_c), jnp.sin(ang_c))


def _rotate(x, cos, sin):
    x1, x2 = jnp.split(x, 2, axis=-1)
    c = cos[None, :, None, :]
    s = sin[None, :, None, :]
    return jnp.concatenate([x1 * c - x2 * s, x1 * s + x2 * c], axis=-1)


def apply_axial_rope(x, tabs):
    cr, sr, cc, sc = tabs
    xr, xc = jnp.split(x.astype(jnp.float32), 2, axis=-1)
    return jnp.concatenate([_rotate(xr, cr, sr), _rotate(xc, cc, sc)], axis=-1).astype(x.dtype)


def global_gqa(q, k, v):
    B, N = q.shape[0], q.shape[1]
    G = N_HEADS_A // N_KV_A
    scale = HEAD_DIM ** -0.5

    def attend(qb):
        L = qb.shape[1]
        qg = qb.reshape(B, L, N_KV_A, G, HEAD_DIM)
        s = jnp.einsum('blkgd,bskd->bkgls', qg, k).astype(jnp.float32) * scale
        p = jax.nn.softmax(s, axis=-1).astype(v.dtype)
        o = jnp.einsum('bkgls,bskd->blkgd', p, v)
        return o.reshape(B, L, D_A)

    o_meta = attend(q[:, :N_META])
    S = N - N_META
    nb = S // Q_BLOCK
    q_blocks = q[:, N_META:].reshape(B, nb, Q_BLOCK, N_HEADS_A, HEAD_DIM).transpose(1, 0, 2, 3, 4)
    o_real = lax.map(attend, q_blocks)
    o_real = o_real.transpose(1, 0, 2, 3).reshape(B, S, D_A)
    return jnp.concatenate([o_meta, o_real], axis=1)


def neighbourhood_tables(n_tok):
    rows = n_tok // GRID_W
    kr = min(WIN_R_MAX, rows)
    t = jnp.arange(n_tok, dtype=jnp.int32)
    r = t // GRID_W
    c = t % GRID_W
    r0 = jnp.clip(r - kr // 2, 0, rows - kr)
    c0 = jnp.clip(c - WIN_C // 2, 0, GRID_W - WIN_C)
    kr_idx = r0[:, None] + jnp.arange(kr, dtype=jnp.int32)[None, :]
    kc_idx = c0[:, None] + jnp.arange(WIN_C, dtype=jnp.int32)[None, :]
    key_idx = (kr_idx[:, :, None] * GRID_W + kc_idx[:, None, :]).reshape(n_tok, kr * WIN_C)
    off_r = kr_idx - r[:, None] + (WIN_R_MAX - 1)
    off_c = kc_idx - c[:, None] + (WIN_C - 1)
    bias_idx = (off_r[:, :, None] * (2 * WIN_C - 1) + off_c[:, None, :]).reshape(n_tok, kr * WIN_C)
    return key_idx, bias_idx


def neighbourhood_attention(q, k, v, rpb):
    B, N, H, Dh = q.shape
    S = N - N_META
    key_idx, bias_idx = neighbourhood_tables(S)
    W = key_idx.shape[1]
    rpb_flat = rpb.reshape(H, -1).astype(jnp.float32)
    scale = Dh ** -0.5
    qm, km, vm = q[:, :N_META], k[:, :N_META], v[:, :N_META]
    kx, vx = k[:, N_META:], v[:, N_META:]
    sm = jnp.einsum('bqhd,bkhd->bhqk', qm, km).astype(jnp.float32) * scale
    o_meta = jnp.einsum('bhqk,bkhd->bqhd', jax.nn.softmax(sm, axis=-1).astype(v.dtype), vm)

    def attend(args):
        qb, kidx, bidx = args
        kg = kx[:, kidx]
        vg = vx[:, kidx]
        s_win = jnp.einsum('bqhd,bqwhd->bhqw', qb, kg).astype(jnp.float32) * scale + rpb_flat[:, bidx][None]
        s_meta = jnp.einsum('bqhd,bkhd->bhqk', qb, km).astype(jnp.float32) * scale
        p = jax.nn.softmax(jnp.concatenate([s_meta, s_win], axis=-1), axis=-1).astype(v.dtype)
        return (jnp.einsum('bhqk,bkhd->bqhd', p[..., :N_META], vm)
                + jnp.einsum('bhqw,bqwhd->bqhd', p[..., N_META:], vg))

    nb = S // Q_BLOCK
    q_blocks = q[:, N_META:].reshape(B, nb, Q_BLOCK, H, Dh).transpose(1, 0, 2, 3, 4)
    o_real = lax.map(attend, (q_blocks, key_idx.reshape(nb, Q_BLOCK, W), bias_idx.reshape(nb, Q_BLOCK, W)))
    o_real = o_real.transpose(1, 0, 2, 3, 4).reshape(B, S, H * Dh)
    return jnp.concatenate([o_meta.reshape(B, N_META, H * Dh), o_real], axis=1)


def encoder_layer(h, norm_w, w_in, q_norm_a, k_norm_a, q_norm_b, k_norm_b, rpb, w_out, rope_tabs):
    B, N, _ = h.shape
    u = rms_norm(h, norm_w) @ w_in.astype(h.dtype)
    qa, ka, va, za, qb, kb, vb, zb = jnp.split(u, split_points(), axis=-1)
    qa = apply_axial_rope(rms_norm(qa.reshape(B, N, N_HEADS_A, HEAD_DIM), q_norm_a), rope_tabs)
    ka = apply_axial_rope(rms_norm(ka.reshape(B, N, N_KV_A, HEAD_DIM), k_norm_a), rope_tabs)
    va = va.reshape(B, N, N_KV_A, HEAD_DIM)
    ya = global_gqa(qa, ka, va) * jax.nn.silu(za)
    qb = rms_norm(qb.reshape(B, N, N_HEADS_B, HEAD_DIM), q_norm_b)
    kb = rms_norm(kb.reshape(B, N, N_HEADS_B, HEAD_DIM), k_norm_b)
    vb = vb.reshape(B, N, N_HEADS_B, HEAD_DIM)
    yb = neighbourhood_attention(qb, kb, vb, rpb) * jax.nn.silu(zb)
    y = jnp.concatenate([ya, yb], axis=-1) @ w_out.astype(h.dtype)
    return h + y


def setup_inputs(seed: int = 0) -> dict:
    key = jax.random.key(seed)
    ks = jax.random.split(key, 12)
    f32 = jnp.float32
    return {
        "x_prompt": jax.random.normal(ks[0], (BATCH, SEQ, D_MODEL), f32),
        "x_sample": jax.random.normal(ks[1], (DEC_BATCH, DEC_SEQ, D_MODEL), f32),
        "meta_tokens": jax.random.normal(ks[2], (N_META, D_MODEL), f32),
        "norm_w": 1.0 + 0.02 * jax.random.normal(ks[3], (DEPTH, D_MODEL), f32),
        "w_in": jax.random.normal(ks[4], (DEPTH, D_MODEL, D_IN), f32) * D_MODEL ** -0.5,
        "q_norm_a": 1.0 + 0.02 * jax.random.normal(ks[5], (DEPTH, HEAD_DIM), f32),
        "k_norm_a": 1.0 + 0.02 * jax.random.normal(ks[6], (DEPTH, HEAD_DIM), f32),
        "q_norm_b": 1.0 + 0.02 * jax.random.normal(ks[7], (DEPTH, HEAD_DIM), f32),
        "k_norm_b": 1.0 + 0.02 * jax.random.normal(ks[8], (DEPTH, HEAD_DIM), f32),
        "rpb": 0.1 * jax.random.normal(ks[9], (DEPTH, N_HEADS_B, 2 * WIN_R_MAX - 1, 2 * WIN_C - 1), f32),
        "w_out": jax.random.normal(ks[10], (DEPTH, D_MIX, D_MODEL), f32) * D_MIX ** -0.5,
    }


def reference(x_prompt, x_sample, meta_tokens, norm_w, w_in, q_norm_a, k_norm_a, q_norm_b, k_norm_b, rpb, w_out):
    def encode(x):
        B, S, _ = x.shape
        meta = jnp.broadcast_to(meta_tokens.astype(x.dtype)[None], (B, N_META, D_MODEL))
        h = jnp.concatenate([meta, x], axis=1)
        tabs = axial_rope_tables(S)
        for l in range(DEPTH):
            h = encoder_layer(h, norm_w[l], w_in[l], q_norm_a[l], k_norm_a[l],
                              q_norm_b[l], k_norm_b[l], rpb[l], w_out[l], tabs)
        return h[:, N_META:]

    y_prompt = encode(x_prompt)
    y_sample = encode(x_sample)
    return (y_prompt, y_sample)
```

```cpp
#include <hip/hip_runtime.h>
#include <hip/hip_cooperative_groups.h>
#include <cstdio>
#include <cstdint>
namespace cg = cooperative_groups;

#ifndef PH_MASK
#define PH_MASK 15
#endif
#ifndef DUP_MASK
#define DUP_MASK 0
#endif
#ifndef MK_COOP
#define MK_COOP 1
#endif

#define LAS __attribute__((address_space(3)))
typedef unsigned short bf16_t;
typedef short bf16x8 __attribute__((ext_vector_type(8)));
typedef short s16x4 __attribute__((ext_vector_type(4)));
typedef float f32x4 __attribute__((ext_vector_type(4)));
typedef float f32x16 __attribute__((ext_vector_type(16)));
typedef unsigned u32x4 __attribute__((ext_vector_type(4)));
typedef unsigned u32x2 __attribute__((ext_vector_type(2)));
typedef int v8i __attribute__((ext_vector_type(8)));

constexpr int DM = 2048;
constexpr int NTOK = 16384;
constexpr int META_ROW0 = 16384;
constexpr int MROWS = 16640;
constexpr int NIN = 6656;
constexpr int NQ = 2048;
constexpr int C_QA = 0, C_QB = 1024;
constexpr int NU = 4608;
constexpr int C_KA = 0, C_VA = 256, C_ZA = 512, C_KB = 1536, C_VB = 2560, C_ZB = 3584;
constexpr float EPS = 1e-6f;
constexpr int NWAVES = 8;
constexpr int LDS_BYTES = 147456;
constexpr int MISC_OFF = 131072;

constexpr size_t WS_Q = 0, WS_U = (size_t)66 << 20, WS_WOUT = (size_t)213 << 20, WS_BAR = (size_t)221 << 20, WS_BAR_BYTES = 16384, WS_KF8 = (size_t)222 << 20, WS_WIN8 = (size_t)227 << 20, WS_END = (size_t)241 << 20;
constexpr size_t OUT_XN = 0, OUT_WIN = (size_t)66 << 20, OUT_XN8 = (size_t)92 << 20;
static_assert(OUT_XN8 + (size_t)MROWS * DM <= (size_t)NTOK * DM * 4 && WS_WIN8 + (size_t)NIN * DM <= WS_END && (size_t)MROWS * NQ * 2 <= WS_U && WS_U + (size_t)MROWS * NU * 2 <= WS_WOUT && (size_t)MROWS * DM * 2 <= OUT_WIN && OUT_WIN + (size_t)NIN * DM * 2 <= (size_t)NTOK * DM * 4, "maps");

__device__ __forceinline__ unsigned cvtpk(float lo, float hi) { unsigned r; asm volatile("v_cvt_pk_bf16_f32 %0, %1, %2" : "=v"(r) : "v"(lo), "v"(hi)); return r; }
__device__ __forceinline__ unsigned pk4_fp8(float a, float b, float c, float d) { int w = __builtin_amdgcn_cvt_pk_fp8_f32(a, b, 0, false); w = __builtin_amdgcn_cvt_pk_fp8_f32(c, d, w, true); return (unsigned)w; }
__device__ __forceinline__ float bflo(unsigned w) { return __uint_as_float(w << 16); }
__device__ __forceinline__ float bfhi(unsigned w) { return __uint_as_float(w & 0xffff0000u); }
__device__ __forceinline__ float bf2f(unsigned short b) { return __uint_as_float(((unsigned)b) << 16); }
__device__ __forceinline__ unsigned f2bf(float f) { unsigned u = __float_as_uint(f); return (u + 0x7fffu + ((u >> 16) & 1u)) >> 16; }
__device__ __forceinline__ float wave_sum(float v) {
#pragma unroll
    for (int o = 1; o < 64; o <<= 1) v += __shfl_xor(v, o);
    return v;
}
__device__ __forceinline__ int lane_id_v() { int l; asm volatile("v_mbcnt_lo_u32_b32 %0, -1, 0\n\tv_mbcnt_hi_u32_b32 %0, -1, %0" : "=v"(l)); return l; }
__device__ __forceinline__ float inv_freq(int j) { return __builtin_amdgcn_exp2f(-0.4152410118609203f * (float)j); }
__device__ __forceinline__ void sincos_rev(float ang, float& s, float& c) { const float r = ang * 0.15915494309189535f; s = __builtin_amdgcn_sinf(r); c = __builtin_amdgcn_cosf(r); }
__device__ __forceinline__ float silu(float z) { return z * __builtin_amdgcn_rcpf(1.f + __builtin_amdgcn_exp2f(-1.4426950408889634f * z)); }

namespace pg8 {
constexpr int BM = 256, BK = 64, HALF = 128, HTB = HALF * BK * 2, NXCD = 8, WGM = 8;
__host__ __device__ __forceinline__ int lds_byte(int r, int c) { const int st = (r >> 4) * 2 + (c >> 5), rr = r & 15, cc = c & 31, ob = rr * 64 + cc * 2; return st * 1024 + (ob ^ (((ob >> 9) & 1) << 5)); }
__host__ __device__ __forceinline__ void stage_rc(int b, int& R, int& C) { const int st = b / 1024, sb = b % 1024, swz = sb ^ (((sb >> 9) & 1) << 5); R = (st >> 1) * 16 + swz / 64; C = (st & 1) * 32 + (swz % 64) / 2; }
__host__ __device__ __forceinline__ int perm32(int rho) { const int n = rho >> 4, i = rho & 15; return 8 * (i >> 2) + 4 * n + (i & 3); }
struct Unit { int pm, pn; };
struct Gemm { const void* A; const void* Bt; int ldaB; int ldbB; int nt; };

struct Order {
    int nM, nN, nwg, G, c, nextra, mode;
    __device__ void init(int nM_, int nN_, int G_, int c_, int nextra_, int mode_ = 0) { nM = nM_; nN = nN_; nwg = nM * nN; G = G_; c = c_; nextra = nextra_; mode = mode_; }
    __device__ bool next(int i, Unit& u) const {
        const long L = (long)i * G + c; if (L >= nwg + nextra) return false;
        if (L >= nwg) { const int e = (int)(L - nwg); u.pm = nM; u.pn = e < 2 ? 8 + e : 12 + e; return true; }
        int wgid = (int)L; { const int q = nwg / NXCD, r = nwg % NXCD, xcd = wgid % NXCD, off = wgid / NXCD; wgid = (xcd < r ? xcd * (q + 1) : r * (q + 1) + (xcd - r) * q) + off; }
        const int nig = WGM * nN, gid = wgid / nig, fm = gid * WGM, gsz = (nM - fm) < WGM ? (nM - fm) : WGM;
        u.pm = fm + ((wgid % nig) % gsz); u.pn = (wgid % nig) / gsz;
        if (mode == 1) u.pn = u.pn < 4 ? 4 + u.pn : 10 + u.pn; else if (mode == 2) u.pn = u.pn < 4 ? u.pn : 4 + u.pn;
        return true;
    }
};

struct EpiU {
    static constexpr bool PERM = true;
    bf16_t* Qbuf; bf16_t* U; unsigned char* Kf8; const float* kna; const float* knb; LAS float* xch;
    __device__ __forceinline__ void init(f32x4 (&acc)[2][2][4][2], const Unit&, int, int, int, int) const {
#pragma unroll
        for (int a = 0; a < 2; ++a)
#pragma unroll
            for (int b = 0; b < 2; ++b)
#pragma unroll
                for (int m = 0; m < 4; ++m)
#pragma unroll
                    for (int n = 0; n < 2; ++n) acc[a][b][m][n] = (f32x4){0.f, 0.f, 0.f, 0.f};
    }
    __device__ __forceinline__ void operator()(const f32x4 (&acc)[2][2][4][2], const Unit& u, int wr, int wc, int fr, int fq) const {
        const int row0 = u.pm * BM + wr * 64 + fr;
        const bool isQ = u.pn < 8, isKa = (u.pn == 8), isKb = (u.pn >= 14 && u.pn < 18);
        bf16_t* const dst = isQ ? Qbuf : U; const int ldd = isQ ? NQ : NU, col0 = (isQ ? u.pn : u.pn - 8) * BM + wc * 32 + 8 * fq;
        if (!(isKa || isKb)) {
#pragma unroll
            for (int ai = 0; ai < 2; ++ai)
#pragma unroll
                for (int m = 0; m < 4; ++m) { bf16_t* rowp = dst + (size_t)(row0 + ai * HALF + m * 16) * ldd + col0;
#pragma unroll
                    for (int bj = 0; bj < 2; ++bj) { const f32x4 v0 = acc[ai][bj][m][0], v1 = acc[ai][bj][m][1];
                        u32x4 w; w.x = cvtpk(v0[0], v0[1]); w.y = cvtpk(v0[2], v0[3]); w.z = cvtpk(v1[0], v1[1]); w.w = cvtpk(v1[2], v1[3]);
                        *(u32x4*)(rowp + bj * HALF) = w; } }
            return;
        }
#pragma unroll
        for (int ai = 0; ai < 2; ++ai)
#pragma unroll
            for (int m = 0; m < 4; ++m)
#pragma unroll
                for (int bj = 0; bj < 2; ++bj) { const f32x4 v0 = acc[ai][bj][m][0], v1 = acc[ai][bj][m][1];
                    float ss = (v0[0] * v0[0] + v0[1] * v0[1]) + (v0[2] * v0[2] + v0[3] * v0[3]) + (v1[0] * v1[0] + v1[1] * v1[1]) + (v1[2] * v1[2] + v1[3] * v1[3]);
                    ss += __shfl_xor(ss, 16); ss += __shfl_xor(ss, 32);
                    if (fq == 0) xch[(ai * HALF + wr * 64 + m * 16 + fr) * 8 + bj * 4 + wc] = ss; }
        asm volatile("s_waitcnt lgkmcnt(0)" ::: "memory"); __builtin_amdgcn_s_barrier(); asm volatile("" ::: "memory");
        const int e0 = isKa ? 64 * (wc >> 1) + 16 * (wc & 1) + 4 * fq : 32 * wc + 8 * fq;
        const float* gp = isKa ? kna : knb;
        const f32x4 g0 = *(const f32x4*)(gp + e0), g1 = *(const f32x4*)(gp + e0 + (isKa ? 32 : 4));
        float ifr[4];
#pragma unroll
        for (int i = 0; i < 4; ++i) ifr[i] = inv_freq(16 * (wc & 1) + 4 * fq + i);
#pragma unroll
        for (int ai = 0; ai < 2; ++ai)
#pragma unroll
            for (int m = 0; m < 4; ++m) { const int rl = ai * HALF + wr * 64 + m * 16 + fr, row = u.pm * BM + rl;
                float sn[4], cs[4];
                if (isKa) { float rowpos, colpos;
                    if (row < NTOK) { const int t = row < 8192 ? row : ((row - 8192) & 2047); rowpos = (float)(t >> 6); colpos = (float)(t & 63); } else { rowpos = -1.f; colpos = (float)(row - META_ROW0); }
                    const float pos = (wc >> 1) ? colpos : rowpos;
#pragma unroll
                    for (int i = 0; i < 4; ++i) sincos_rev(pos * ifr[i], sn[i], cs[i]); }
                bf16_t* rowp = U + (size_t)row * NU + col0;
#pragma unroll
                for (int bj = 0; bj < 2; ++bj) { const f32x4 t = *(const LAS f32x4*)(xch + rl * 8 + bj * 4);
                    const float rs = __builtin_amdgcn_rsqf(((t[0] + t[1]) + (t[2] + t[3])) * (1.f / 128.f) + EPS);
                    f32x4 v0 = acc[ai][bj][m][0] * rs * g0, v1 = acc[ai][bj][m][1] * rs * g1;
                    if (isKa) {
#pragma unroll
                        for (int i = 0; i < 4; ++i) { const float x1 = v0[i], x2 = v1[i]; v0[i] = x1 * cs[i] - x2 * sn[i]; v1[i] = x1 * sn[i] + x2 * cs[i]; } }
                    if (isKa) {
                        u32x2 w8; w8.x = pk4_fp8(v0[0], v0[1], v0[2], v0[3]); w8.y = pk4_fp8(v1[0], v1[1], v1[2], v1[3]);
                        *(u32x2*)(Kf8 + (size_t)row * 256 + bj * 128 + (fq & 1) * 64 + (2 * wc + (fq >> 1)) * 8) = w8;
                    } else {
                    u32x4 w; w.x = cvtpk(v0[0], v0[1]); w.y = cvtpk(v0[2], v0[3]); w.z = cvtpk(v1[0], v1[1]); w.w = cvtpk(v1[2], v1[3]);
                    *(u32x4*)(rowp + bj * HALF) = w; } } }
    }
};
struct EpiOut {
    static constexpr bool PERM = false;
    const float* xp; const float* xs; float* out;
    __device__ __forceinline__ void init(f32x4 (&acc)[2][2][4][2], const Unit& u, int wr, int wc, int fr, int fq) const {
        const int row0 = u.pm * BM + wr * 64 + fr, col0 = u.pn * BM + wc * 32 + 4 * fq;
#pragma unroll
        for (int ai = 0; ai < 2; ++ai)
#pragma unroll
            for (int m = 0; m < 4; ++m) { const int row = row0 + ai * HALF + m * 16;
                const float* xr = (row < 8192 ? xp + (size_t)row * DM : xs + (size_t)(row - 8192) * DM) + col0;
#pragma unroll
                for (int bj = 0; bj < 2; ++bj)
#pragma unroll
                    for (int n = 0; n < 2; ++n) acc[ai][bj][m][n] = *(const f32x4*)(xr + bj * HALF + n * 16); }
    }
    __device__ __forceinline__ void operator()(const f32x4 (&acc)[2][2][4][2], const Unit& u, int wr, int wc, int fr, int fq) const {
        const int row0 = u.pm * BM + wr * 64 + fr, col0 = u.pn * BM + wc * 32 + 4 * fq;
#pragma unroll
        for (int ai = 0; ai < 2; ++ai)
#pragma unroll
            for (int m = 0; m < 4; ++m) { float* orow = out + (size_t)(row0 + ai * HALF + m * 16) * DM + col0;
#pragma unroll
                for (int bj = 0; bj < 2; ++bj)
#pragma unroll
                    for (int n = 0; n < 2; ++n) *(f32x4*)(orow + bj * HALF + n * 16) = acc[ai][bj][m][n]; }
    }
};

template <class Epi, class Sched, bool ALIGN_EPI, bool SP2, bool FP8 = false>
__device__ __forceinline__ void gemm_phase(LAS unsigned char* lds, const Gemm g, const Sched& S, const Epi& E, int wid, f32x4 (&acc)[2][2][4][2], bool preinit) {
    const int lane = lane_id_v(), tid = wid * 64 + lane, wr = wid >> 2, wc = wid & 3, fr = lane & 15, fq = lane >> 4;
    const int nt = g.nt, ldaB = g.ldaB, ldbB = g.ldbB;
    unsigned voffA[2], voffB[2];
#pragma unroll
    for (int i = 0; i < 2; ++i) { int R, C; stage_rc(tid * 16 + i * 8192, R, C); const int Rb = Epi::PERM ? ((R & ~31) + perm32(R & 31)) : R;
        voffA[i] = (unsigned)(R * ldaB + C * 2); voffB[i] = (unsigned)(Rb * ldbB + C * 2); }
    const size_t kstep = (size_t)(BK * 2);
    const size_t hstepA = (size_t)HALF * ldaB, hstepB = (size_t)HALF * ldbB;
    const size_t tstepA = 2 * hstepA, tstepB = 2 * hstepB;
    const unsigned ldsw = (unsigned)wid * 1024u;
    const int aoff = lds_byte(wr * 64 + fr, fq * 8), boff = lds_byte(wc * 32 + fr, fq * 8);
#define PG8_SA(b, h) (((b) * 2 + (h)) * HTB)
#define PG8_SB(b, h) ((4 + (b) * 2 + (h)) * HTB)
#define PG8_STAGE(bufoff, gbase, voff) do { _Pragma("unroll") for (int _i = 0; _i < 2; ++_i) \
        __builtin_amdgcn_global_load_lds((const unsigned*)((const char*)(gbase) + (voff)[_i]), (LAS unsigned*)(lds + (bufoff) + ldsw + _i * 8192), 16, 0, 0); } while (0)
#define PG8_LDA(dst, b, h) do { _Pragma("unroll") for (int m = 0; m < 4; ++m) _Pragma("unroll") for (int k = 0; k < 2; ++k) dst[m].k[k] = *(const LAS bf16x8*)(lds + PG8_SA(b, h) + aoff + m * 2048 + k * 1024); } while (0)
#define PG8_LDB(dst, b, h) do { _Pragma("unroll") for (int n = 0; n < 2; ++n) _Pragma("unroll") for (int k = 0; k < 2; ++k) dst[n].k[k] = *(const LAS bf16x8*)(lds + PG8_SB(b, h) + boff + n * 2048 + k * 1024); } while (0)
#define PG8_MMA(ai, bj, At, Bt) do { __builtin_amdgcn_s_setprio(1); if constexpr (FP8) { \
        _Pragma("unroll") for (int m = 0; m < 4; ++m) _Pragma("unroll") for (int n = 0; n < 2; ++n) \
            asm volatile("v_mfma_scale_f32_16x16x128_f8f6f4 %0, %1, %2, %0, %3, %4 op_sel_hi:[0,0,0]" : "+v"(acc[ai][bj][m][n]) : "v"(Bt[n].v), "v"(At[m].v), "v"(sc_w), "v"(sc_x)); \
      } else { _Pragma("unroll") for (int m = 0; m < 4; ++m) _Pragma("unroll") for (int n = 0; n < 2; ++n) _Pragma("unroll") for (int k = 0; k < 2; ++k) \
        acc[ai][bj][m][n] = __builtin_amdgcn_mfma_f32_16x16x32_bf16(Bt[n].k[k], At[m].k[k], acc[ai][bj][m][n], 0, 0, 0); } __builtin_amdgcn_s_setprio(0); } while (0)
#define PG8_WAIT_V(n) asm volatile("s_waitcnt vmcnt(" #n ")" ::: "memory")
#define PG8_WAIT_L(n) asm volatile("s_waitcnt lgkmcnt(" #n ")" ::: "memory")
#define PG8_BAR __builtin_amdgcn_s_barrier()
#define PG8_SCHED __builtin_amdgcn_sched_barrier(0)
    Unit cur, nxt; int ui = 0;
    if (!S.next(0, cur)) return;
    if (!preinit) E.init(acc, cur, wr, wc, fr, fq);
    union FragU { v8i v; bf16x8 k[2]; };
    FragU At[4], B0[2], B1[2];
    const int sc_w = 0x79797979, sc_x = 0x7F7F7F7F;
    const char* cA = (const char*)g.A + (size_t)cur.pm * tstepA; const char* cB = (const char*)g.Bt + (size_t)cur.pn * tstepB;
    if constexpr (SP2) {
        PG8_STAGE(PG8_SB(0, 0), cB, voffB); PG8_STAGE(PG8_SB(0, 1), cB + hstepB, voffB); PG8_STAGE(PG8_SA(0, 0), cA, voffA); PG8_STAGE(PG8_SA(0, 1), cA + hstepA, voffA);
        if (wr == 1) PG8_BAR;
        PG8_WAIT_V(2); PG8_BAR;
        PG8_STAGE(PG8_SB(1, 0), cB + kstep, voffB); PG8_STAGE(PG8_SA(1, 0), cA + kstep, voffA); PG8_STAGE(PG8_SB(1, 1), cB + hstepB + kstep, voffB);
        PG8_WAIT_V(6); PG8_BAR;
    } else {
        PG8_STAGE(PG8_SB(0, 0), cB, voffB); PG8_STAGE(PG8_SA(0, 0), cA, voffA); PG8_STAGE(PG8_SB(0, 1), cB + hstepB, voffB); PG8_STAGE(PG8_SA(0, 1), cA + hstepA, voffA);
        if (wr == 1) PG8_BAR;
        PG8_WAIT_V(4); PG8_BAR;
        PG8_STAGE(PG8_SB(1, 0), cB + kstep, voffB); PG8_STAGE(PG8_SA(1, 0), cA + kstep, voffA); PG8_STAGE(PG8_SB(1, 1), cB + hstepB + kstep, voffB);
        PG8_WAIT_V(6); PG8_BAR;
    }
    for (;;) {
        const bool has_next = S.next(ui + 1, nxt);
        const char* nA = has_next ? (const char*)g.A + (size_t)nxt.pm * tstepA : cA; const char* nB = has_next ? (const char*)g.Bt + (size_t)nxt.pn * tstepB : cB;
        for (int t = 0; t < nt; t += 2) {
            const bool last = (t == nt - 2);
            const char* a1 = cA + (size_t)(t + 1) * kstep;
            const char* a2 = last ? nA : cA + (size_t)(t + 2) * kstep; const char* b2 = last ? nB : cB + (size_t)(t + 2) * kstep;
            const char* a3 = a2 + kstep; const char* b3 = b2 + kstep;
            if constexpr (SP2) {
            PG8_LDB(B0, 0, 0); PG8_LDB(B1, 0, 1); PG8_SCHED; PG8_LDA(At, 0, 0); PG8_STAGE(PG8_SA(1, 1), a1 + hstepA, voffA);
            PG8_WAIT_V(8); PG8_WAIT_L(0); PG8_BAR; PG8_MMA(0, 0, At, B0); PG8_MMA(0, 1, At, B1); PG8_BAR; PG8_SCHED;
            PG8_LDA(At, 0, 1); PG8_STAGE(PG8_SB(0, 0), b2, voffB); PG8_STAGE(PG8_SB(0, 1), b2 + hstepB, voffB); PG8_STAGE(PG8_SA(0, 0), a2, voffA);
            PG8_WAIT_V(8); PG8_WAIT_L(0); PG8_BAR; PG8_MMA(1, 0, At, B0); PG8_MMA(1, 1, At, B1); PG8_BAR; PG8_SCHED;
            PG8_LDB(B0, 1, 0); PG8_LDB(B1, 1, 1); PG8_SCHED; PG8_LDA(At, 1, 0); PG8_STAGE(PG8_SA(0, 1), a2 + hstepA, voffA);
            PG8_WAIT_V(8); PG8_WAIT_L(0); PG8_BAR; PG8_MMA(0, 0, At, B0); PG8_MMA(0, 1, At, B1); PG8_BAR; PG8_SCHED;
            PG8_LDA(At, 1, 1); PG8_STAGE(PG8_SB(1, 0), b3, voffB); PG8_STAGE(PG8_SB(1, 1), b3 + hstepB, voffB); PG8_STAGE(PG8_SA(1, 0), a3, voffA);
            PG8_WAIT_V(8); PG8_WAIT_L(0); PG8_BAR; PG8_MMA(1, 0, At, B0); PG8_MMA(1, 1, At, B1); PG8_BAR; PG8_SCHED;
            } else {
            PG8_LDB(B0, 0, 0); PG8_SCHED; PG8_LDA(At, 0, 0); PG8_STAGE(PG8_SA(1, 1), a1 + hstepA, voffA);
            PG8_WAIT_L(8); PG8_BAR; PG8_WAIT_L(0); PG8_MMA(0, 0, At, B0); PG8_BAR; PG8_SCHED;
            PG8_LDB(B1, 0, 1); PG8_STAGE(PG8_SB(0, 0), b2, voffB);
            PG8_BAR; PG8_WAIT_L(0); PG8_MMA(0, 1, At, B1); PG8_BAR;
            PG8_LDA(At, 0, 1); PG8_STAGE(PG8_SA(0, 0), a2, voffA);
            PG8_BAR; PG8_WAIT_L(0); PG8_MMA(1, 0, At, B0); PG8_BAR; PG8_SCHED;
            PG8_STAGE(PG8_SB(0, 1), b2 + hstepB, voffB);
            PG8_WAIT_V(6); PG8_BAR; PG8_MMA(1, 1, At, B1); PG8_BAR;
            PG8_LDB(B0, 1, 0); PG8_SCHED; PG8_LDA(At, 1, 0); PG8_STAGE(PG8_SA(0, 1), a2 + hstepA, voffA);
            PG8_WAIT_L(8); PG8_BAR; PG8_WAIT_L(0); PG8_MMA(0, 0, At, B0); PG8_BAR; PG8_SCHED;
            PG8_LDB(B1, 1, 1); PG8_STAGE(PG8_SB(1, 0), b3, voffB);
            PG8_BAR; PG8_WAIT_L(0); PG8_MMA(0, 1, At, B1); PG8_BAR;
            PG8_LDA(At, 1, 1); PG8_STAGE(PG8_SA(1, 0), a3, voffA);
            PG8_BAR; PG8_WAIT_L(0); PG8_MMA(1, 0, At, B0); PG8_BAR; PG8_SCHED;
            PG8_STAGE(PG8_SB(1, 1), b3 + hstepB, voffB);
            PG8_WAIT_V(6); PG8_BAR; PG8_MMA(1, 1, At, B1); PG8_BAR;
            }
        }
        if constexpr (ALIGN_EPI) { if (wr == 0) PG8_BAR; }
        if constexpr (FP8) asm volatile("s_nop 15\n\ts_nop 15" ::: "memory");
        E(acc, cur, wr, wc, fr, fq);
        if (!has_next) break;
        E.init(acc, nxt, wr, wc, fr, fq);
        cur = nxt; cA = nA; cB = nB; ++ui;
        if constexpr (ALIGN_EPI) { if (wr == 1) PG8_BAR; }
    }
    PG8_WAIT_V(0);
    if constexpr (!ALIGN_EPI) { if (wr == 0) PG8_BAR; }
    PG8_BAR;
#undef PG8_SA
#undef PG8_SB
#undef PG8_STAGE
#undef PG8_LDA
#undef PG8_LDB
#undef PG8_MMA
#undef PG8_WAIT_V
#undef PG8_WAIT_L
#undef PG8_BAR
#undef PG8_SCHED
}
}

namespace att {
constexpr int D = 128, NW = 8, QBLK = 32, KVBLK = 64;
constexpr float SCALE = 0.088388347648318440f, INV_SCALE = 11.313708498984761f;
constexpr float THR = 8.f;
constexpr float NEG = -1e30f;
constexpr int LD = NU;
constexpr int SHM_V = KVBLK * D * 2, SHM_K = KVBLK * D * 2;
#define KSWZ(row, colB) ((row) * 256 + ((colB) ^ (((row) & 7) << 4)))
#define SBAR() __builtin_amdgcn_sched_barrier(0)
__device__ __forceinline__ int crow(int r, int hi) { return (r & 3) + 8 * (r >> 2) + 4 * hi; }

__device__ __forceinline__ void partialSM(f32x16& p0, f32x16& p1, float& m_reg, float& mn, float& alpha) {
  constexpr float C = SCALE * 1.4426950408889634f;
  float pmax = p0[0];
#pragma unroll
  for (int r = 1; r < 16; ++r) pmax = fmaxf(pmax, p0[r]);
#pragma unroll
  for (int r = 0; r < 16; ++r) pmax = fmaxf(pmax, p1[r]);
  { auto rr = __builtin_amdgcn_permlane32_swap(__float_as_uint(pmax), __float_as_uint(pmax), false, false);
    pmax = fmaxf(__uint_as_float(rr[0]), __uint_as_float(rr[1])); }
  if (__builtin_expect(__all(pmax - m_reg <= THR / SCALE), 1)) { mn = m_reg; alpha = 1.f; }
  else { mn = fmaxf(m_reg, pmax); alpha = __builtin_amdgcn_exp2f((m_reg - mn) * C); m_reg = mn; }
  float mnC = -mn * C;
#pragma unroll
  for (int r = 0; r < 16; ++r) p0[r] = fmaf(p0[r], C, mnC);
#pragma unroll
  for (int r = 0; r < 16; ++r) p1[r] = fmaf(p1[r], C, mnC);
#pragma unroll
  for (int r = 0; r < 16; ++r) p0[r] = __builtin_amdgcn_exp2f(p0[r]);
}
__device__ __forceinline__ void partialSM_fix(f32x16& p0, f32x16& p1, float negBC) {
  constexpr float C = SCALE * 1.4426950408889634f;
#pragma unroll
  for (int r = 0; r < 16; ++r) p0[r] = fmaf(p0[r], C, negBC);
#pragma unroll
  for (int r = 0; r < 16; ++r) p1[r] = fmaf(p1[r], C, negBC);
#pragma unroll
  for (int r = 0; r < 16; ++r) p0[r] = __builtin_amdgcn_exp2f(p0[r]);
}
__device__ __forceinline__ void finishSM(f32x16& p0, f32x16& p1, float alpha, float& l_reg, bf16x8& pa0, bf16x8& pa1, bf16x8& pa2, bf16x8& pa3) {
#pragma unroll
  for (int r = 0; r < 16; ++r) p1[r] = __builtin_amdgcn_exp2f(p1[r]);
  float ps = 0;
#pragma unroll
  for (int r = 0; r < 16; ++r) ps += p0[r];
#pragma unroll
  for (int r = 0; r < 16; ++r) ps += p1[r];
  { auto rr = __builtin_amdgcn_permlane32_swap(__float_as_uint(ps), __float_as_uint(ps), false, false);
    ps = __uint_as_float(rr[0]) + __uint_as_float(rr[1]); }
  l_reg = l_reg * alpha + ps;
#define PK4(P, BASE, OUT) do { unsigned a0 = cvtpk(P[BASE + 0], P[BASE + 1]), a1 = cvtpk(P[BASE + 2], P[BASE + 3]);   \
    unsigned b0 = cvtpk(P[BASE + 4], P[BASE + 5]), b1 = cvtpk(P[BASE + 6], P[BASE + 7]);                              \
    auto r0 = __builtin_amdgcn_permlane32_swap(a0, b0, false, false); auto r1 = __builtin_amdgcn_permlane32_swap(a1, b1, false, false); \
    u32x4 w = {r0[0], r1[0], r0[1], r1[1]}; OUT = *reinterpret_cast<bf16x8*>(&w); } while (0)
  PK4(p0, 0, pa0); PK4(p0, 8, pa1); PK4(p1, 0, pa2); PK4(p1, 8, pa3);
#undef PK4
}
__device__ __forceinline__ void qkt(f32x16& p0, f32x16& p1, const char* Ks, const bf16x8* qr, int r32, int hi) {
  p0 = f32x16{}; p1 = f32x16{};
#pragma unroll
  for (int d0 = 0; d0 < 8; ++d0) { int cb = (d0 * 16 + hi * 8) * 2;
    bf16x8 b0 = *reinterpret_cast<const bf16x8*>(Ks + KSWZ(r32, cb));
    bf16x8 b1 = *reinterpret_cast<const bf16x8*>(Ks + KSWZ(32 + r32, cb));
    p0 = __builtin_amdgcn_mfma_f32_32x32x16_bf16(b0, qr[d0], p0, 0, 0, 0);
    p1 = __builtin_amdgcn_mfma_f32_32x32x16_bf16(b1, qr[d0], p1, 0, 0, 0); }
}
__device__ __forceinline__ int v_st(int k, int c) { const int kk = (k & ~0xC) | ((k & 4) << 1) | ((k & 8) >> 1); return ((kk >> 3) * 4 + (c >> 5)) * 512 + ((kk & 7) * 32 + (c & 31)) * 2; }
__device__ __forceinline__ int v_rd_base(int lane) { return ((lane & 3) << 3) | (((lane >> 2) & 3) << 6) | (((lane >> 4) & 1) << 5) | (((lane >> 5) & 1) << 8); }
constexpr int v_rd_off(int d0, int ks, int half) { return d0 * 512 + ks * 4096 + half * 2048; }
template <int OFF> __device__ __forceinline__ s16x4 tr_read(int vb) {
  s16x4 r; asm volatile("ds_read_b64_tr_b16 %0, %1 offset:%2" : "=&v"(r) : "v"(vb), "i"(OFF) : "memory"); return r;
}
template <int D0> __device__ __forceinline__ void pv_one(f32x16& od, int vb, bf16x8 pa0, bf16x8 pa1, bf16x8 pa2, bf16x8 pa3) {
  const s16x4 l0 = tr_read<v_rd_off(D0, 0, 0)>(vb), h0 = tr_read<v_rd_off(D0, 0, 1)>(vb), l1 = tr_read<v_rd_off(D0, 1, 0)>(vb), h1 = tr_read<v_rd_off(D0, 1, 1)>(vb);
  const s16x4 l2 = tr_read<v_rd_off(D0, 2, 0)>(vb), h2 = tr_read<v_rd_off(D0, 2, 1)>(vb), l3 = tr_read<v_rd_off(D0, 3, 0)>(vb), h3 = tr_read<v_rd_off(D0, 3, 1)>(vb);
  asm volatile("s_waitcnt lgkmcnt(0)" ::: "memory"); SBAR();
#define PK(L, H) (bf16x8){L[0], L[1], L[2], L[3], H[0], H[1], H[2], H[3]}
  od = __builtin_amdgcn_mfma_f32_32x32x16_bf16(pa0, PK(l0, h0), od, 0, 0, 0);
  od = __builtin_amdgcn_mfma_f32_32x32x16_bf16(pa1, PK(l1, h1), od, 0, 0, 0);
  od = __builtin_amdgcn_mfma_f32_32x32x16_bf16(pa2, PK(l2, h2), od, 0, 0, 0);
  od = __builtin_amdgcn_mfma_f32_32x32x16_bf16(pa3, PK(l3, h3), od, 0, 0, 0);
#undef PK
}
__device__ __forceinline__ void pv_d0(f32x16* o, int vb, bf16x8 pa0, bf16x8 pa1, bf16x8 pa2, bf16x8 pa3) {
  pv_one<0>(o[0], vb, pa0, pa1, pa2, pa3); pv_one<1>(o[1], vb, pa0, pa1, pa2, pa3); pv_one<2>(o[2], vb, pa0, pa1, pa2, pa3); pv_one<3>(o[3], vb, pa0, pa1, pa2, pa3);
}

#define PV_RD(D0, A0, A1, A2, A3, A4, A5, A6, A7) do { A0 = tr_read<v_rd_off(D0, 0, 0)>(vb); A1 = tr_read<v_rd_off(D0, 0, 1)>(vb); A2 = tr_read<v_rd_off(D0, 1, 0)>(vb); A3 = tr_read<v_rd_off(D0, 1, 1)>(vb); \
    A4 = tr_read<v_rd_off(D0, 2, 0)>(vb); A5 = tr_read<v_rd_off(D0, 2, 1)>(vb); A6 = tr_read<v_rd_off(D0, 3, 0)>(vb); A7 = tr_read<v_rd_off(D0, 3, 1)>(vb); } while (0)
#define PV_PK(L, H) (bf16x8){L[0], L[1], L[2], L[3], H[0], H[1], H[2], H[3]}
#define PV_MM(OD, A0, A1, A2, A3, A4, A5, A6, A7) do { OD = __builtin_amdgcn_mfma_f32_32x32x16_bf16(pa0, PV_PK(A0, A1), OD, 0, 0, 0); OD = __builtin_amdgcn_mfma_f32_32x32x16_bf16(pa1, PV_PK(A2, A3), OD, 0, 0, 0); \
    OD = __builtin_amdgcn_mfma_f32_32x32x16_bf16(pa2, PV_PK(A4, A5), OD, 0, 0, 0); OD = __builtin_amdgcn_mfma_f32_32x32x16_bf16(pa3, PV_PK(A6, A7), OD, 0, 0, 0); } while (0)
__device__ __forceinline__ void pv_pipe(f32x16* o, int vb, bf16x8 pa0, bf16x8 pa1, bf16x8 pa2, bf16x8 pa3) {
  s16x4 a0, a1, a2, a3, a4, a5, a6, a7, b0, b1, b2, b3, b4, b5, b6, b7;
  PV_RD(0, a0, a1, a2, a3, a4, a5, a6, a7);
  PV_RD(1, b0, b1, b2, b3, b4, b5, b6, b7);
  asm volatile("s_waitcnt lgkmcnt(8)" ::: "memory"); SBAR();
  PV_MM(o[0], a0, a1, a2, a3, a4, a5, a6, a7);
  PV_RD(2, a0, a1, a2, a3, a4, a5, a6, a7);
  asm volatile("s_waitcnt lgkmcnt(8)" ::: "memory"); SBAR();
  PV_MM(o[1], b0, b1, b2, b3, b4, b5, b6, b7);
  PV_RD(3, b0, b1, b2, b3, b4, b5, b6, b7);
  asm volatile("s_waitcnt lgkmcnt(8)" ::: "memory"); SBAR();
  PV_MM(o[2], a0, a1, a2, a3, a4, a5, a6, a7);
  asm volatile("s_waitcnt lgkmcnt(0)" ::: "memory"); SBAR();
  PV_MM(o[3], b0, b1, b2, b3, b4, b5, b6, b7);
}

template <int OFF> __device__ __forceinline__ bf16x8 k_read(int addr) { bf16x8 r; asm volatile("ds_read_b128 %0, %1 offset:%2" : "=&v"(r) : "v"(addr), "i"(OFF) : "memory"); return r; }
#define K_RD(D0, X0, X1) do { X0 = k_read<((D0) >> 2) * 128>(kb[(D0) & 3]); X1 = k_read<((D0) >> 2) * 128 + 8192>(kb[(D0) & 3]); } while (0)
#define K_MM(D0, X0, X1) do { p0 = __builtin_amdgcn_mfma_f32_32x32x16_bf16(X0, qr[D0], p0, 0, 0, 0); p1 = __builtin_amdgcn_mfma_f32_32x32x16_bf16(X1, qr[D0], p1, 0, 0, 0); } while (0)
#define LGKM(n) asm volatile("s_waitcnt lgkmcnt(" #n ")" ::: "memory")
__device__ __forceinline__ void qkt_pipe(f32x16& p0, f32x16& p1, const int* kb, const bf16x8* qr) {
  bf16x8 x0, x1, y0, y1, z0, z1;
  K_RD(0, x0, x1); K_RD(1, y0, y1); K_RD(2, z0, z1);
  p0 = f32x16{}; p1 = f32x16{};
  LGKM(4); SBAR(); K_MM(0, x0, x1); K_RD(3, x0, x1);
  LGKM(4); SBAR(); K_MM(1, y0, y1); K_RD(4, y0, y1);
  LGKM(4); SBAR(); K_MM(2, z0, z1); K_RD(5, z0, z1);
  LGKM(4); SBAR(); K_MM(3, x0, x1); K_RD(6, x0, x1);
  LGKM(4); SBAR(); K_MM(4, y0, y1); K_RD(7, y0, y1);
  LGKM(4); SBAR(); K_MM(5, z0, z1);
  LGKM(2); SBAR(); K_MM(6, x0, x1);
  LGKM(0); SBAR(); K_MM(7, y0, y1);
}

template <bool ROPE>
__device__ __forceinline__ void q_prologue(bf16x8* qr, v8i* q8, const bf16_t* Qw, const float* __restrict__ gain, int hi, float rowpos, float colpos) {
  float qf[8][8]; float ss = 0.f;
#pragma unroll
  for (int d0 = 0; d0 < 8; ++d0) { const u32x4 v = *reinterpret_cast<const u32x4*>(Qw + d0 * 16);
    qf[d0][0] = bflo(v.x); qf[d0][1] = bfhi(v.x); qf[d0][2] = bflo(v.y); qf[d0][3] = bfhi(v.y); qf[d0][4] = bflo(v.z); qf[d0][5] = bfhi(v.z); qf[d0][6] = bflo(v.w); qf[d0][7] = bfhi(v.w);
#pragma unroll
    for (int i = 0; i < 8; ++i) ss = fmaf(qf[d0][i], qf[d0][i], ss); }
  { auto rr = __builtin_amdgcn_permlane32_swap(__float_as_uint(ss), __float_as_uint(ss), false, false); ss = __uint_as_float(rr[0]) + __uint_as_float(rr[1]); }
  const float rs = __builtin_amdgcn_rsqf(ss * (1.f / 128.f) + EPS);
#pragma unroll
  for (int d0 = 0; d0 < 8; ++d0) {
    const int base = ROPE ? 64 * (d0 >> 2) + 16 * ((d0 >> 1) & 1) + 8 * (d0 & 1) + 4 * hi : d0 * 16 + hi * 8;
    const f32x4 g0 = *reinterpret_cast<const f32x4*>(gain + base), g1 = *reinterpret_cast<const f32x4*>(gain + base + (ROPE ? 32 : 4));
#pragma unroll
    for (int i = 0; i < 4; ++i) { qf[d0][i] *= rs * g0[i]; qf[d0][4 + i] *= rs * g1[i]; } }
  if constexpr (ROPE) {
#pragma unroll
    for (int d0 = 0; d0 < 8; ++d0) { const float pos = (d0 >> 2) ? colpos : rowpos;
#pragma unroll
      for (int i = 0; i < 4; ++i) { const int j = 16 * ((d0 >> 1) & 1) + 8 * (d0 & 1) + 4 * hi + i; float sn, c; sincos_rev(pos * inv_freq(j), sn, c);
        const float x1 = qf[d0][i], x2 = qf[d0][i + 4];
        qf[d0][i] = x1 * c - x2 * sn; qf[d0][i + 4] = x1 * sn + x2 * c; } }
  }
  if constexpr (ROPE) {
    constexpr float QS = SCALE * 1.4426950408889634f * 8.f;
#pragma unroll
    for (int kk = 0; kk < 2; ++kk)
#pragma unroll
      for (int c = 0; c < 4; ++c) { q8[kk][2 * c] = (int)pk4_fp8(qf[4 * kk + c][0] * QS, qf[4 * kk + c][1] * QS, qf[4 * kk + c][2] * QS, qf[4 * kk + c][3] * QS); q8[kk][2 * c + 1] = (int)pk4_fp8(qf[4 * kk + c][4] * QS, qf[4 * kk + c][5] * QS, qf[4 * kk + c][6] * QS, qf[4 * kk + c][7] * QS); }
  } else {
#pragma unroll
  for (int d0 = 0; d0 < 8; ++d0) { u32x4 w = {cvtpk(qf[d0][0], qf[d0][1]), cvtpk(qf[d0][2], qf[d0][3]), cvtpk(qf[d0][4], qf[d0][5]), cvtpk(qf[d0][6], qf[d0][7])}; qr[d0] = *reinterpret_cast<bf16x8*>(&w); }
  }
}

__device__ __forceinline__ void o_epilogue(const f32x16* o, float l_reg, float* li_l, bf16_t* Ow, const bf16_t* Zw, int r32, int hi) {
  if (hi == 0) li_l[r32] = l_reg; asm volatile("s_waitcnt lgkmcnt(0)" ::: "memory");
  const unsigned zoff = (unsigned)(4 * hi * LD + r32), ooff = (unsigned)(4 * hi * NQ + r32);
#pragma unroll
  for (int r = 0; r < 16; ++r) { const int rc = (r & 3) + 8 * (r >> 2); const float rl = __builtin_amdgcn_rcpf(li_l[rc + 4 * hi]);
    const bf16_t* zr = Zw + (size_t)rc * LD; bf16_t* orw = Ow + (size_t)rc * NQ;
#pragma unroll
    for (int d0 = 0; d0 < 4; ++d0) { const float z = bf2f(zr[zoff + d0 * 32]); orw[ooff + d0 * 32] = (bf16_t)f2bf(o[d0][r] * rl * silu(z)); } }
}

constexpr int SHM_K8 = KVBLK * 128;
__device__ __forceinline__ void qkt8(f32x16& p0, f32x16& p1, const char* Ks, const v8i* q8, int r32, int hi) {
  p0 = f32x16{}; p1 = f32x16{};
  const int sw = (r32 >> 1) & 7; const char* rowp = Ks + r32 * 128;
#pragma unroll
  for (int kk = 0; kk < 2; ++kk) {
    const int c0 = ((4 * hi + 2 * kk) ^ sw) << 4, c1 = ((4 * hi + 2 * kk + 1) ^ sw) << 4;
    const u32x4 a0 = *reinterpret_cast<const u32x4*>(rowp + c0), a1 = *reinterpret_cast<const u32x4*>(rowp + c1);
    const u32x4 b0 = *reinterpret_cast<const u32x4*>(rowp + 4096 + c0), b1 = *reinterpret_cast<const u32x4*>(rowp + 4096 + c1);
    const v8i ka = {(int)a0.x, (int)a0.y, (int)a0.z, (int)a0.w, (int)a1.x, (int)a1.y, (int)a1.z, (int)a1.w};
    const v8i kb = {(int)b0.x, (int)b0.y, (int)b0.z, (int)b0.w, (int)b1.x, (int)b1.y, (int)b1.z, (int)b1.w};
    p0 = __builtin_amdgcn_mfma_scale_f32_32x32x64_f8f6f4(ka, q8[kk], p0, 0, 0, 0, 0x7F7F7F7F, 0, 0x7C7C7C7C);
    p1 = __builtin_amdgcn_mfma_scale_f32_32x32x64_f8f6f4(kb, q8[kk], p1, 0, 0, 0, 0x7F7F7F7F, 0, 0x7C7C7C7C); }
}

constexpr int NSLOT = 4, RING_V = NSLOT * SHM_K;
__device__ __forceinline__ void attnA_item(const bf16_t* Qb, bf16_t* Ob, const bf16_t* __restrict__ Zb, const unsigned char* __restrict__ Kmeta, const bf16_t* __restrict__ Vmeta,
                                           const unsigned char* __restrict__ Kreal, const bf16_t* __restrict__ Vreal, int S, int t0, const float* __restrict__ gain, float negBC, char* lds, float* wsbase, int wid) {
  const int lane = lane_id_v(), r32 = lane & 31, hi = lane >> 5;
  float* ws = wsbase + wid * 64; float* li_l = ws; float* al_l = ws + 32;
  float l_reg = 0; f32x16 o[4] = {}; v8i q8[2];
  unsigned koff, voff[2];
  { const int row = wid * 8 + (lane >> 3), c = (lane & 7) ^ ((row >> 1) & 7); koff = (unsigned)(row * 256 + c * 16); }
#pragma unroll
  for (int i = 0; i < 2; ++i) { const int b = (wid * 2 + i) * 1024 + lane * 16;
    { const int sub = b >> 9, w = b & 511, kk = (sub >> 2) * 8 + (w >> 6), k = (kk & ~0xC) | ((kk & 4) << 1) | ((kk & 8) >> 1), c = (sub & 3) * 32 + ((w & 63) >> 1); voff[i] = (unsigned)(k * LD * 2 + c * 2); } }
  const int NT = 1 + S / KVBLK;
  LAS unsigned char* ldsl = (LAS unsigned char*)lds;
#define DLOAD(tt) do { const int _t = (tt) < NT ? (tt) : NT - 1; const int _s = (tt) & (NSLOT - 1); \
    const char* _k = (const char*)(_t == 0 ? Kmeta : Kreal + (size_t)(_t - 1) * KVBLK * 256); const char* _v = (const char*)(_t == 0 ? Vmeta : Vreal + (size_t)(_t - 1) * KVBLK * LD); \
    __builtin_amdgcn_global_load_lds((const unsigned*)(_k + koff), (LAS unsigned*)(ldsl + _s * SHM_K8 + wid * 1024), 16, 0, 0); \
    _Pragma("unroll") for (int _i = 0; _i < 2; ++_i) \
      __builtin_amdgcn_global_load_lds((const unsigned*)(_v + voff[_i]), (LAS unsigned*)(ldsl + RING_V + _s * SHM_V + (wid * 2 + _i) * 1024), 16, 0, 0); } while (0)
#define KSLOT(t) (lds + ((t) & (NSLOT - 1)) * SHM_K8)
#define VSLOT(t) (vb0 + ((t) & (NSLOT - 1)) * SHM_V)
#define LANDED() do { asm volatile("s_waitcnt vmcnt(4)" ::: "memory"); __builtin_amdgcn_s_barrier(); asm volatile("" ::: "memory"); } while (0)
#define RESC(a) do { if (__any((a) < 1.f)) { if (hi == 0) al_l[r32] = (a); asm volatile("s_waitcnt lgkmcnt(0)" ::: "memory"); \
    _Pragma("unroll") for (int d = 0; d < 4; ++d) _Pragma("unroll") for (int r = 0; r < 16; ++r) o[d][r] *= al_l[crow(r, hi)]; } } while (0)
  const int vb0 = (int)(uintptr_t)(lds + RING_V) + v_rd_base(lane);
  f32x16 p0, p1; bf16x8 pa0, pa1, pa2, pa3;
  const int grp = wid >> 2;
#define BAR() do { asm volatile("" ::: "memory"); __builtin_amdgcn_s_barrier(); asm volatile("" ::: "memory"); } while (0)
#define VMW(n) asm volatile("s_waitcnt vmcnt(" #n ")" ::: "memory")
#define VPHASE() do { if (__builtin_expect(negBC != 0.f, 0)) { _Pragma("unroll") for (int r = 0; r < 16; ++r) { p0[r] += negBC; p1[r] += negBC; } } \
    _Pragma("unroll") for (int r = 0; r < 16; ++r) p0[r] = __builtin_amdgcn_exp2f(p0[r]); finishSM(p0, p1, 1.f, l_reg, pa0, pa1, pa2, pa3); } while (0)
#define MPHASE(t) do { __builtin_amdgcn_s_setprio(1); pv_pipe(o, VSLOT(t), pa0, pa1, pa2, pa3); if ((t) + 1 < NT) qkt8(p0, p1, KSLOT((t) + 1), q8, r32, hi); __builtin_amdgcn_s_setprio(0); } while (0)
  __syncthreads();
  DLOAD(0); DLOAD(1);
  { const int t = t0 + wid * QBLK + r32;
    q_prologue<true>(nullptr, q8, Qb + (size_t)(wid * QBLK + r32) * NQ + hi * 8, gain, hi, (float)(t >> 6), (float)(t & 63)); }
  VMW(3); BAR();
  if (grp == 0) {
    qkt8(p0, p1, KSLOT(0), q8, r32, hi);
#pragma unroll
    for (int r = 8; r < 16; ++r) p0[r] = NEG;
#pragma unroll
    for (int r = 0; r < 16; ++r) p1[r] = NEG;
    VMW(0); BAR();
    for (int t = 0; t < NT; ++t) {
      SBAR(); DLOAD(t + 2); SBAR();
      VPHASE();
      VMW(3); BAR();
      MPHASE(t);
      BAR();
    }
    BAR();
  } else {
    BAR();
    SBAR(); DLOAD(2); SBAR();
    qkt8(p0, p1, KSLOT(0), q8, r32, hi);
#pragma unroll
    for (int r = 8; r < 16; ++r) p0[r] = NEG;
#pragma unroll
    for (int r = 0; r < 16; ++r) p1[r] = NEG;
    VMW(3); BAR();
    for (int t = 0; t < NT; ++t) {
      SBAR(); DLOAD(t + 3); SBAR();
      VPHASE();
      BAR();
      MPHASE(t);
      VMW(3); BAR();
    }
  }
  asm volatile("s_waitcnt vmcnt(0)" ::: "memory");
  o_epilogue(o, l_reg, li_l, Ob + (size_t)(wid * QBLK) * NQ, Zb + (size_t)(wid * QBLK) * LD, r32, hi);
#undef BAR
#undef VMW
#undef VPHASE
#undef MPHASE
#undef DLOAD
#undef KSLOT
#undef VSLOT
#undef LANDED
}

__device__ __forceinline__ void na_item(const bf16_t* Qb, bf16_t* Ob, const bf16_t* __restrict__ Zb, const bf16_t* __restrict__ Kmeta, const bf16_t* __restrict__ Vmeta,
                                        const bf16_t* __restrict__ Kseq, const bf16_t* __restrict__ Vseq, int R0, int rows, const float* __restrict__ gain,
                                        const float* __restrict__ rpb_h, float negBC, char* lds, float* wsbase, LAS float* rpbs, int wid) {
  const int lane = lane_id_v(), tid = wid * 64 + lane, r32 = lane & 31, hi = lane >> 5;
  float* ws = wsbase + wid * 64; float* li_l = ws; float* al_l = ws + 32;
  float l_reg = 0; f32x16 o[4] = {}; bf16x8 qr[8];
  unsigned koff[2], voff[2];
#pragma unroll
  for (int i = 0; i < 2; ++i) { const int b = (wid * 2 + i) * 1024 + lane * 16;
    { const int row = b >> 8, cB = (b & 255) ^ ((row & 7) << 4); koff[i] = (unsigned)(row * LD * 2 + cB); }
    { const int sub = b >> 9, w = b & 511, kk = (sub >> 2) * 8 + (w >> 6), k = (kk & ~0xC) | ((kk & 4) << 1) | ((kk & 8) >> 1), c = (sub & 3) * 32 + ((w & 63) >> 1); voff[i] = (unsigned)(k * LD * 2 + c * 2); } }
  const int rmax = rows - 8;
  const int rlo = min(max(R0 - 4, 0), rmax), rhi = min(max(R0 - 1, 0), rmax) + 7, NT = 2 + rhi - rlo;
  const int rq = R0 + (wid >> 1), r0q = min(max(rq - 4, 0), rmax);
  const int par = wid & 1, cq = par * 32 + r32, c0 = min(max(cq - 8, 0), 48);
  LAS unsigned char* ldsl = (LAS unsigned char*)lds;
#define DLOAD(tt) do { const int _t = (tt) < NT ? (tt) : NT - 1; const int _s = (tt) & (NSLOT - 1); \
    const char* _k = (const char*)(_t == 0 ? Kmeta : Kseq + (size_t)(rlo + _t - 1) * 64 * LD); const char* _v = (const char*)(_t == 0 ? Vmeta : Vseq + (size_t)(rlo + _t - 1) * 64 * LD); \
    _Pragma("unroll") for (int _i = 0; _i < 2; ++_i) { \
      __builtin_amdgcn_global_load_lds((const unsigned*)(_k + koff[_i]), (LAS unsigned*)(ldsl + _s * SHM_K + (wid * 2 + _i) * 1024), 16, 0, 0); \
      __builtin_amdgcn_global_load_lds((const unsigned*)(_v + voff[_i]), (LAS unsigned*)(ldsl + RING_V + _s * SHM_V + (wid * 2 + _i) * 1024), 16, 0, 0); } } while (0)
#define LANDED() do { asm volatile("s_waitcnt vmcnt(4)" ::: "memory"); __builtin_amdgcn_s_barrier(); asm volatile("" ::: "memory"); } while (0)
  const int vb0 = (int)(uintptr_t)(lds + RING_V) + v_rd_base(lane);
  __syncthreads();
  for (int i = tid; i < 465; i += 512) rpbs[i] = rpb_h[i] * INV_SCALE;
  DLOAD(0); DLOAD(1);
  q_prologue<false>(qr, nullptr, Qb + (size_t)(wid * QBLK + r32) * NQ + hi * 8, gain, hi, 0.f, 0.f);
  asm volatile("s_waitcnt lgkmcnt(0)" ::: "memory");
  LANDED();
  for (int t = 0; t < NT; ++t) {
    SBAR(); DLOAD(t + 2); SBAR();
    const int rk = rlo + t - 1;
    if (t == 0 || (rk >= r0q && rk < r0q + 8)) {
      f32x16 p0, p1; bf16x8 pa0, pa1, pa2, pa3;
      { const int _ks = (int)(uintptr_t)lds + (t & (NSLOT - 1)) * SHM_K + r32 * 256, _sw = (r32 & 7) << 4;
        const int kb[4] = {_ks + ((0 + hi * 16) ^ _sw), _ks + ((32 + hi * 16) ^ _sw), _ks + ((64 + hi * 16) ^ _sw), _ks + ((96 + hi * 16) ^ _sw)};
        asm volatile("s_waitcnt lgkmcnt(0)" ::: "memory"); SBAR();
        qkt_pipe(p0, p1, kb, qr); }
      if (t == 0) {
#pragma unroll
        for (int r = 8; r < 16; ++r) p0[r] = NEG;
#pragma unroll
        for (int r = 0; r < 16; ++r) p1[r] = NEG;
      } else {
        const LAS float* brow = rpbs + (rk - rq + 7) * 31 + (15 - cq);
#define MB(P, r, ckb) do { const int ck = (ckb) + crow(r, hi); const bool v = (unsigned)(ck - c0) < 16u; const float b = brow[v ? ck : cq]; P[r] = v ? P[r] + b : NEG; } while (0)
        if (par == 0) {
#pragma unroll
          for (int r = 0; r < 16; ++r) MB(p0, r, 0);
#pragma unroll
          for (int r = 0; r < 4; ++r) MB(p1, r, 32);
#pragma unroll
          for (int r = 4; r < 16; ++r) p1[r] = NEG;
        } else {
#pragma unroll
          for (int r = 0; r < 12; ++r) p0[r] = NEG;
#pragma unroll
          for (int r = 12; r < 16; ++r) MB(p0, r, 0);
#pragma unroll
          for (int r = 0; r < 16; ++r) MB(p1, r, 32);
        }
#undef MB
      }
      partialSM_fix(p0, p1, negBC);
      finishSM(p0, p1, 1.f, l_reg, pa0, pa1, pa2, pa3);
      asm volatile("s_waitcnt lgkmcnt(0)" ::: "memory"); SBAR();
      pv_pipe(o, vb0 + (t & (NSLOT - 1)) * SHM_V, pa0, pa1, pa2, pa3);
    }
    LANDED();
  }
  asm volatile("s_waitcnt vmcnt(0)" ::: "memory");
  o_epilogue(o, l_reg, li_l, Ob + (size_t)(wid * QBLK) * NQ, Zb + (size_t)(wid * QBLK) * LD, r32, hi);
#undef DLOAD
#undef LANDED
#undef RESC
}
}


#define XB_TMO      128
#define XB_XCNT(j)  (256  + 64 * (j))
#define XB_XSUB(j)  (1280 + 64 * (j))
#define XB_XGEN(j)  (2304 + 64 * (j))
#define XB_TOP      3328
#define XB_TOPGEN   3392
#define XCD_BAR_WORDS 3456
#define XB_SPIN_CAP (1u << 18)
__device__ __forceinline__ unsigned xb_ld(unsigned* p)              { return __hip_atomic_load(p, __ATOMIC_RELAXED, __HIP_MEMORY_SCOPE_AGENT); }
__device__ __forceinline__ unsigned xb_add(unsigned* p, unsigned v) { return __hip_atomic_fetch_add(p, v, __ATOMIC_RELAXED, __HIP_MEMORY_SCOPE_AGENT); }
__device__ __forceinline__ unsigned xb_xcc_id() { return (unsigned)__builtin_amdgcn_s_getreg((3 << 11) | 20) & 0xFu; }
#define XB_SPIN(cond, bar) do { unsigned _sp = 0; while (cond) { __builtin_amdgcn_s_sleep(1); \
    if ((++_sp & 255u) == 0u) { if (xb_ld(&(bar)[XB_TMO])) break; if (_sp > XB_SPIN_CAP) { atomicAdd(&(bar)[XB_TMO], 1u); break; } } } } while (0)
struct XcdBarrier { unsigned* bar; unsigned x; volatile LAS unsigned* st; };
__device__ __forceinline__ void xcd_barrier_complete(unsigned* bar, unsigned x, unsigned& nloc, unsigned& nx) {
    const unsigned G = gridDim.x * gridDim.y * gridDim.z;
    unsigned sum, cnt, mine, sp = 0u;
    for (;;) {
        sum = 0u; cnt = 0u; mine = 0u;
#pragma unroll
        for (unsigned j = 0; j < 16; ++j) { const unsigned c = xb_ld(&bar[XB_XCNT(j)]); sum += c; cnt += (c > 0u) ? 1u : 0u; mine = (j == x) ? c : mine; }
        if (sum == G) break;
        __builtin_amdgcn_s_sleep(1);
        if ((++sp & 255u) == 0u) { if (xb_ld(&bar[XB_TMO])) break; if (sp > XB_SPIN_CAP) { atomicAdd(&bar[XB_TMO], 1u); break; } }
    }
    nloc = mine > 0u ? mine : 1u; nx = cnt > 0u ? cnt : 1u;
}
__device__ __forceinline__ void xcd_barrier(const XcdBarrier& b, bool t0) {
    asm volatile("s_waitcnt vmcnt(0)" ::: "memory");
    __syncthreads();
    if (t0) {
        unsigned* bar = b.bar;
        __builtin_amdgcn_s_waitcnt(0);
        unsigned nloc = b.st[0], nx = b.st[1];
        if (nloc == 0u) { xcd_barrier_complete(bar, b.x, nloc, nx); b.st[0] = nloc; b.st[1] = nx; }
        const unsigned old = xb_add(&bar[XB_XSUB(b.x)], 1u);
        const unsigned gen = old / nloc;
        if (old + 1u == (gen + 1u) * nloc) {
            __builtin_amdgcn_fence(__ATOMIC_RELEASE, "agent");
            asm volatile("s_waitcnt vmcnt(0)" ::: "memory");
            const unsigned og = xb_add(&bar[XB_TOP], 1u);
            const unsigned tg = og / nx;
            if (og + 1u == (tg + 1u) * nx) xb_add(&bar[XB_TOPGEN], 1u);
            else XB_SPIN(xb_ld(&bar[XB_TOPGEN]) == tg, bar);
            __builtin_amdgcn_fence(__ATOMIC_ACQUIRE, "agent");
            xb_add(&bar[XB_XGEN(b.x)], 1u);
            asm volatile("s_waitcnt vmcnt(0)" ::: "memory");
        } else {
            XB_SPIN(xb_ld(&bar[XB_XGEN(b.x)]) == gen, bar);
            __builtin_amdgcn_fence(__ATOMIC_ACQUIRE, "agent");
            asm volatile("s_waitcnt vmcnt(0)" ::: "memory");
        }
    }
    __syncthreads();
}

__device__ __forceinline__ void transpose_item(const float* __restrict__ W, int K, int N, bf16_t* __restrict__ WT, unsigned char* __restrict__ WT8, int k0, int n0, int dst_n0, int sig, LAS float* scr, int lane) {
    float t[32];
#pragma unroll
    for (int i = 0; i < 32; ++i) t[i] = W[(size_t)(k0 + 2 * i + (lane >> 5)) * N + n0 + (lane & 31)];
#pragma unroll
    for (int i = 0; i < 32; ++i) scr[(2 * i + (lane >> 5)) * 33 + (lane & 31)] = t[i];
    asm volatile("s_waitcnt lgkmcnt(0)" ::: "memory");
    const int c = lane & 7;
#pragma unroll
    for (int j = 0; j < 4; ++j) { const int n = (lane >> 3) + 8 * j; const LAS float* sp = scr + (8 * c) * 33 + n;
        const int drow = sig < 0 ? dst_n0 + n : dst_n0 + 64 * (sig >> 6) + 4 * ((sig >> 5) & 1) + 32 * (n >> 4) + 8 * ((n >> 2) & 3) + (n & 3);
        u32x4 o; o.x = cvtpk(sp[0 * 33], sp[1 * 33]); o.y = cvtpk(sp[2 * 33], sp[3 * 33]); o.z = cvtpk(sp[4 * 33], sp[5 * 33]); o.w = cvtpk(sp[6 * 33], sp[7 * 33]);
        if (!(WT8 && drow < 3584 && (drow < 1024 || drow >= 2048))) *(u32x4*)(WT + (size_t)drow * K + k0 + 8 * c) = o;
        if (WT8) { u32x2 o8; o8.x = pk4_fp8(sp[0 * 33] * 64.f, sp[1 * 33] * 64.f, sp[2 * 33] * 64.f, sp[3 * 33] * 64.f); o8.y = pk4_fp8(sp[4 * 33] * 64.f, sp[5 * 33] * 64.f, sp[6 * 33] * 64.f, sp[7 * 33] * 64.f);
            *(u32x2*)(WT8 + (size_t)drow * K + k0 + 8 * c) = o8; } }
    asm volatile("s_waitcnt lgkmcnt(0)" ::: "memory");
}
__device__ __forceinline__ int remap_in_col(int n0) {
    if (n0 < 1024) return n0;
    if (n0 < 1280) return 2048 + (n0 - 1024);
    if (n0 < 1536) return 2304 + (n0 - 1280);
    if (n0 < 2560) return 2560 + (n0 - 1536);
    if (n0 < 3584) return 1024 + (n0 - 2560);
    return n0;
}

struct Args { const float* x_prompt; const float* x_sample; const float* meta; const float* norm_w; const float* w_in; const float* qna; const float* kna; const float* qnb; const float* knb;
              const float* rpb; const float* w_out; float* out; unsigned char* ws; int ph_lo, ph_hi; };

__global__ void __launch_bounds__(NWAVES * 64, 2) hymba_fwd(Args a) {
    extern __shared__ __attribute__((aligned(16))) unsigned char lds[];
    const int wave = __builtin_amdgcn_readfirstlane(threadIdx.x >> 6);
    const int G = gridDim.x, bx = blockIdx.x;
    const int lo = a.ph_lo, hi_ph = a.ph_hi;
    bf16_t* Qbuf = (bf16_t*)(a.ws + WS_Q); bf16_t* U = (bf16_t*)(a.ws + WS_U); bf16_t* WoutT = (bf16_t*)(a.ws + WS_WOUT);
    bf16_t* XN = (bf16_t*)((unsigned char*)a.out + OUT_XN); bf16_t* WinT = (bf16_t*)((unsigned char*)a.out + OUT_WIN);
#define IN(k) ((((PH_MASK) >> (k)) & 1) && lo <= (k) && (k) < hi_ph)
    volatile LAS unsigned* bst = (volatile LAS unsigned*)((LAS unsigned char*)lds + MISC_OFF + 4096);
    const bool t0 = (wave == 0) && (lane_id_v() == 0);
    XcdBarrier bar; bar.bar = (unsigned*)(a.ws + WS_BAR); bar.x = xb_xcc_id(); bar.st = bst;
    if (hi_ph - lo > 1) { if (t0) { bst[0] = 0u; bst[1] = 0u; (void)xb_add(&bar.bar[XB_XCNT(bar.x)], 1u); } __syncthreads(); }
    if (lo < 0) cg::this_grid().sync();
#define SEAM(k) do { if (IN(k) && IN((k) + 1)) xcd_barrier(bar, (wave == 0) && (lane_id_v() == 0)); } while (0)

    for (int rep = 0; rep < 1 + ((DUP_MASK >> 0) & 1); ++rep)
    if (IN(0)) {
        const int lane = lane_id_v();
        LAS float* scr = (LAS float*)((LAS unsigned char*)lds + wave * 16384);
        const int gw = bx * NWAVES + wave, NGW = G * NWAVES;
        constexpr int I_IN = (DM / 64) * (NIN / 32);
        for (int it = gw; it < I_IN; it += NGW) {
            const int nblk = NIN / 32, kb = it / nblk, nb = it % nblk; const int n0 = 32 * nb; const bool rope = n0 < 1280;
            transpose_item(a.w_in, DM, NIN, WinT, a.ws + WS_WIN8, 64 * kb, n0, rope ? remap_in_col(n0 & ~127) : remap_in_col(n0), rope ? (n0 & 127) : -1, scr, lane);
        }
        for (int m0 = gw; m0 < MROWS; m0 += 2 * NGW) {
            f32x4 v[2][8]; float s[2] = {0.f, 0.f};
#pragma unroll
            for (int u = 0; u < 2; ++u) { const int m = m0 + u * NGW;
                if (m < META_ROW0 + 16) {
                    const float* xrow = m < 8192 ? a.x_prompt + (size_t)m * DM : (m < NTOK ? a.x_sample + (size_t)(m - 8192) * DM : a.meta + (size_t)(m - META_ROW0) * DM);
                    const f32x4* xr = (const f32x4*)xrow + lane;
#pragma unroll
                    for (int j = 0; j < 8; ++j) v[u][j] = xr[64 * j];
                } else {
#pragma unroll
                    for (int j = 0; j < 8; ++j) v[u][j] = (f32x4){0.f, 0.f, 0.f, 0.f};
                } }
#pragma unroll
            for (int u = 0; u < 2; ++u)
#pragma unroll
                for (int j = 0; j < 8; ++j) s[u] += (v[u][j].x * v[u][j].x + v[u][j].y * v[u][j].y) + (v[u][j].z * v[u][j].z + v[u][j].w * v[u][j].w);
#pragma unroll
            for (int o = 1; o < 64; o <<= 1) { s[0] += __shfl_xor(s[0], o); s[1] += __shfl_xor(s[1], o); }
            const f32x4* gw4 = (const f32x4*)a.norm_w + lane;
#pragma unroll
            for (int u = 0; u < 2; ++u) { const int m = m0 + u * NGW; if (m >= MROWS) continue;
                const float rs = __builtin_amdgcn_rsqf(s[u] * (1.f / DM) + EPS);
                unsigned long long* o8 = (unsigned long long*)(XN + (size_t)m * DM) + lane; unsigned* o4 = (unsigned*)((unsigned char*)a.out + OUT_XN8 + (size_t)m * DM) + lane;
#pragma unroll
                for (int j = 0; j < 8; ++j) { const f32x4 g = gw4[64 * j]; const float y0 = v[u][j].x * rs * g.x, y1 = v[u][j].y * rs * g.y, y2 = v[u][j].z * rs * g.z, y3 = v[u][j].w * rs * g.w;
                    o8[64 * j] = (unsigned long long)cvtpk(y0, y1) | ((unsigned long long)cvtpk(y2, y3) << 32); o4[64 * j] = pk4_fp8(y0, y1, y2, y3); } }
        }
    }
    SEAM(0);

    for (int rep = 0; rep < 1 + ((DUP_MASK >> 1) & 1); ++rep)
    if (IN(1)) {
        pg8::EpiU E{Qbuf, U, a.ws + WS_KF8, a.kna, a.knb, (LAS float*)((LAS unsigned char*)lds + MISC_OFF + 8192)};
        { pg8::Gemm g{XN, WinT, DM * 2, DM * 2, DM / 64}; pg8::Order S; S.init(NTOK / 256, 16, G, bx, 0, 1);
          f32x4 acc1[2][2][4][2]; pg8::gemm_phase<pg8::EpiU, pg8::Order, true, true, false>((LAS unsigned char*)lds, g, S, E, wave, acc1, false); }
        { pg8::Gemm g{(unsigned char*)a.out + OUT_XN8, a.ws + WS_WIN8, DM, DM, DM / 128}; pg8::Order S; S.init(NTOK / 256, 10, G, bx, 10, 2);
          f32x4 acc1[2][2][4][2]; pg8::gemm_phase<pg8::EpiU, pg8::Order, true, true, true>((LAS unsigned char*)lds, g, S, E, wave, acc1, false); }
        { constexpr int FIRST = (64 * 10 + 10) - 2 * 256; const int nidle = G - FIRST;
          if (G == 256 ? bx >= FIRST : true) { const int lane = lane_id_v(); LAS float* scr = (LAS float*)((LAS unsigned char*)lds + wave * 16384);
            const int gw = (G == 256 ? bx - FIRST : bx) * NWAVES + wave, NGW = (G == 256 ? nidle : G) * NWAVES; constexpr int I_OUT = (DM / 64) * (DM / 32);
            for (int it = gw; it < I_OUT; it += NGW) { const int nblk = DM / 32, kb = it / nblk, nb = it % nblk; transpose_item(a.w_out, DM, DM, WoutT, nullptr, 64 * kb, 32 * nb, 32 * nb, -1, scr, lane); } } }
    }
    float negBC_a = 0.f, negBC_b = 0.f;
    if (IN(2)) {
        { const int ln = lane_id_v(); float gq = fmaxf(fabsf(a.qna[ln]), fabsf(a.qna[ln + 64])), gk = fmaxf(fabsf(a.kna[ln]), fabsf(a.kna[ln + 64]));
#pragma unroll
          for (int o = 1; o < 64; o <<= 1) { gq = fmaxf(gq, __shfl_xor(gq, o)); gk = fmaxf(gk, __shfl_xor(gk, o)); }
          negBC_a = fminf(0.f, 60.f - 11.313708498984761f * gq * gk * 1.4426950408889634f); }
        { const int ln = lane_id_v(); float gq = fmaxf(fabsf(a.qnb[ln]), fabsf(a.qnb[ln + 64])), gk = fmaxf(fabsf(a.knb[ln]), fabsf(a.knb[ln + 64])), bm = 0.f;
          for (int i = ln; i < 8 * 465; i += 64) bm = fmaxf(bm, fabsf(a.rpb[i]));
#pragma unroll
          for (int o = 1; o < 64; o <<= 1) { gq = fmaxf(gq, __shfl_xor(gq, o)); gk = fmaxf(gk, __shfl_xor(gk, o)); bm = fmaxf(bm, __shfl_xor(bm, o)); }
          negBC_b = -(11.313708498984761f * gq * gk + bm) * 1.4426950408889634f; }
    }
    SEAM(1);

    if (IN(2)) {
        const bf16_t* Umeta = U + (size_t)META_ROW0 * NU; const unsigned char* Kf8 = a.ws + WS_KF8;
#ifndef NO_ATT_A
        for (int rep = 0; rep < 1 + ((DUP_MASK >> 5) & 1); ++rep)
        for (int it = bx; it < 512; it += G) {
            const int h = it & 7, r = (it & 255) >> 3; int base, S, qb;
            if (it < 256) { base = 0; S = 8192; qb = r; } else { base = 8192 + (r >> 3) * 2048; S = 2048; qb = r & 7; }
            const int g = h >> 2;
            bf16_t* Qb = Qbuf + (size_t)(base + qb * 256) * NQ + C_QA + h * 128;
            const bf16_t* Zb = U + (size_t)(base + qb * 256) * NU + C_ZA + h * 128;
            att::attnA_item(Qb, (DUP_MASK & 32) && rep == 0 ? (bf16_t*)a.out : Qb, Zb, Kf8 + (size_t)META_ROW0 * 256 + g * 128, Umeta + C_VA + g * 128, Kf8 + (size_t)base * 256 + g * 128, U + (size_t)base * NU + C_VA + g * 128,
                            S, qb * 256, a.qna, negBC_a, (char*)lds, (float*)((char*)lds + MISC_OFF + 2048), wave);
        }
#endif
#ifndef NO_ATT_NA
        unsigned* na_ctr = (unsigned*)(a.ws + WS_BAR) + 3520; volatile LAS int* qslot = (volatile LAS int*)((LAS unsigned char*)lds + MISC_OFF + 4096 + 32);
        for (;;) {
            __syncthreads();
            if (wave == 0 && lane_id_v() == 0) *qslot = (int)__hip_atomic_fetch_add(na_ctr, 1u, __ATOMIC_RELAXED, __HIP_MEMORY_SCOPE_AGENT);
            __syncthreads();
            const int it = __builtin_amdgcn_readfirstlane(*qslot);
            if (it >= 512) break;
            const int rep = 1;
            const int h = it & 7, tbq = it >> 3; int tb;
            if (tbq < 30) tb = 1 + tbq; else if (tbq < 54) { const int e = tbq - 30; tb = 32 + 8 * (e / 6) + 1 + e % 6; }
            else { const int c = tbq - 54; tb = c == 0 ? 0 : (c == 1 ? 31 : 32 + 8 * ((c - 2) >> 1) + (((c - 2) & 1) ? 7 : 0)); }
            int base, rows, lb;
            if (tb < 32) { base = 0; rows = 128; lb = tb; } else { base = 8192 + ((tb - 32) >> 3) * 2048; rows = 32; lb = (tb - 32) & 7; }
            bf16_t* Qb = Qbuf + (size_t)(base + lb * 256) * NQ + C_QB + h * 128;
            const bf16_t* Zb = U + (size_t)(base + lb * 256) * NU + C_ZB + h * 128;
            att::na_item(Qb, (DUP_MASK & 64) && rep == 0 ? (bf16_t*)a.out : Qb, Zb, Umeta + C_KB + h * 128, Umeta + C_VB + h * 128, U + (size_t)base * NU + C_KB + h * 128, U + (size_t)base * NU + C_VB + h * 128,
                         lb * 4, rows, a.qnb, a.rpb + h * 465, negBC_b, (char*)lds, (float*)((char*)lds + MISC_OFF + 2048), (LAS float*)((LAS unsigned char*)lds + MISC_OFF), wave);
        }
#endif
    }
    f32x4 acc3[2][2][4][2]; bool pre3 = false;
    if (IN(2) && IN(3)) { pg8::Order S3; S3.init(NTOK / 256, DM / 256, G, bx, 0); pg8::Unit u0;
        if (S3.next(0, u0)) { const int ln = lane_id_v(); pg8::EpiOut E3{a.x_prompt, a.x_sample, a.out}; E3.init(acc3, u0, wave >> 2, wave & 3, ln & 15, ln >> 4); pre3 = true; } }
    SEAM(2);

    for (int rep = 0; rep < 1 + ((DUP_MASK >> 4) & 1); ++rep)
    if (IN(3)) {
        __syncthreads();
        pg8::Gemm g{Qbuf, WoutT, NQ * 2, DM * 2, DM / 64}; pg8::Order S; S.init(NTOK / 256, DM / 256, G, bx, 0);
        pg8::EpiOut E{a.x_prompt, a.x_sample, a.out};
        pg8::gemm_phase<pg8::EpiOut, pg8::Order, true, true>((LAS unsigned char*)lds, g, S, E, wave, acc3, pre3 && rep == 0);
    }
#undef IN
#undef SEAM
}

extern "C" void kernel_launch(void* const* d_in, const int* in_sizes, int n_in, void* d_out, int out_size, void* d_ws, size_t ws_size, hipStream_t stream) {
    static int grid = 0;
    if (grid == 0) {
        if (n_in != 11 || out_size != NTOK * DM || ws_size < WS_END) { fprintf(stderr, "kernel_launch: unexpected shapes (n_in %d out %d ws %zu)\n", n_in, out_size, ws_size); grid = -1; return; }
        int dev = 0, cus = 0, per_cu = 0;
        if (hipGetDevice(&dev) != hipSuccess || hipDeviceGetAttribute(&cus, hipDeviceAttributeMultiprocessorCount, dev) != hipSuccess) { grid = -1; return; }
        if (hipFuncSetAttribute((const void*)hymba_fwd, hipFuncAttributeMaxDynamicSharedMemorySize, LDS_BYTES) != hipSuccess) { fprintf(stderr, "kernel_launch: hipFuncSetAttribute failed\n"); grid = -1; return; }
        if (hipOccupancyMaxActiveBlocksPerMultiprocessor(&per_cu, (const void*)hymba_fwd, NWAVES * 64, LDS_BYTES) != hipSuccess || per_cu < 1) { fprintf(stderr, "kernel_launch: occupancy query says %d\n", per_cu); per_cu = 1; }
        (void)hipGetLastError();
        grid = cus * per_cu;
    }
    if (grid < 0) return;
    if (MK_COOP && hipMemsetAsync((char*)d_ws + WS_BAR, 0, WS_BAR_BYTES, stream) != hipSuccess) { fprintf(stderr, "kernel_launch: memset failed\n"); return; }
    Args a{};
    a.x_prompt = (const float*)d_in[0]; a.x_sample = (const float*)d_in[1]; a.meta = (const float*)d_in[2]; a.norm_w = (const float*)d_in[3]; a.w_in = (const float*)d_in[4];
    a.qna = (const float*)d_in[5]; a.kna = (const float*)d_in[6]; a.qnb = (const float*)d_in[7]; a.knb = (const float*)d_in[8]; a.rpb = (const float*)d_in[9]; a.w_out = (const float*)d_in[10];
    a.out = (float*)d_out; a.ws = (unsigned char*)d_ws;
#if MK_COOP
    a.ph_lo = 0; a.ph_hi = 4;
    void* args[] = {&a};
    hipError_t e = hipLaunchCooperativeKernel((const void*)hymba_fwd, dim3(grid), dim3(NWAVES * 64), args, LDS_BYTES, stream);
    if (e != hipSuccess) fprintf(stderr, "kernel_launch: cooperative launch failed: %s (grid %d)\n", hipGetErrorString(e), grid);
#else
    for (int ph = 0; ph < 4; ++ph) {
        a.ph_lo = ph; a.ph_hi = ph + 1;
        hipLaunchKernelGGL(hymba_fwd, dim3(grid), dim3(NWAVES * 64), LDS_BYTES, stream, a);
    }
    const hipError_t le = hipPeekAtLastError();
    if (le != hipSuccess) fprintf(stderr, "kernel_launch: launch failed: %s\n", hipGetErrorName(le));
#endif
}
```

```cpp
#include <hip/hip_runtime.h>
#include <hip/hip_cooperative_groups.h>
#include <cstdio>
#include <cstdint>
namespace cg = cooperative_groups;

#ifndef PH_MASK
#define PH_MASK 15
#endif
#ifndef DUP_MASK
#define DUP_MASK 0
#endif
#ifndef MK_COOP
#define MK_COOP 1
#endif

#define LAS __attribute__((address_space(3)))
typedef unsigned short bf16_t;
typedef short bf16x8 __attribute__((ext_vector_type(8)));
typedef short s16x4 __attribute__((ext_vector_type(4)));
typedef float f32x4 __attribute__((ext_vector_type(4)));
typedef float f32x16 __attribute__((ext_vector_type(16)));
typedef unsigned u32x4 __attribute__((ext_vector_type(4)));
typedef unsigned u32x2 __attribute__((ext_vector_type(2)));
typedef int v8i __attribute__((ext_vector_type(8)));

constexpr int DM = 2048;
constexpr int NTOK = 16384;
constexpr int META_ROW0 = 16384;
constexpr int MROWS = 16640;
constexpr int NIN = 6656;
constexpr int NQ = 2048;
constexpr int C_QA = 0, C_QB = 1024;
constexpr int NU = 4608;
constexpr int C_KA = 0, C_VA = 256, C_ZA = 512, C_KB = 1536, C_VB = 2560, C_ZB = 3584;
constexpr float EPS = 1e-6f;
constexpr int NWAVES = 8;
constexpr int LDS_BYTES = 147456;
constexpr int MISC_OFF = 131072;

constexpr size_t WS_Q = 0, WS_U = (size_t)66 << 20, WS_WOUT = (size_t)213 << 20, WS_BAR = (size_t)221 << 20, WS_BAR_BYTES = 16384, WS_KF8 = (size_t)222 << 20, WS_WIN8 = (size_t)227 << 20, WS_END = (size_t)241 << 20;
constexpr size_t OUT_XN = 0, OUT_WIN = (size_t)66 << 20, OUT_XN8 = (size_t)92 << 20;
static_assert(OUT_XN8 + (size_t)MROWS * DM <= (size_t)NTOK * DM * 4 && WS_WIN8 + (size_t)NIN * DM <= WS_END && (size_t)MROWS * NQ * 2 <= WS_U && WS_U + (size_t)MROWS * NU * 2 <= WS_WOUT && (size_t)MROWS * DM * 2 <= OUT_WIN && OUT_WIN + (size_t)NIN * DM * 2 <= (size_t)NTOK * DM * 4, "maps");

__device__ __forceinline__ unsigned cvtpk(float lo, float hi) { unsigned r; asm volatile("v_cvt_pk_bf16_f32 %0, %1, %2" : "=v"(r) : "v"(lo), "v"(hi)); return r; }
__device__ __forceinline__ unsigned pk4_fp8(float a, float b, float c, float d) { int w = __builtin_amdgcn_cvt_pk_fp8_f32(a, b, 0, false); w = __builtin_amdgcn_cvt_pk_fp8_f32(c, d, w, true); return (unsigned)w; }
__device__ __forceinline__ float bflo(unsigned w) { return __uint_as_float(w << 16); }
__device__ __forceinline__ float bfhi(unsigned w) { return __uint_as_float(w & 0xffff0000u); }
__device__ __forceinline__ float bf2f(unsigned short b) { return __uint_as_float(((unsigned)b) << 16); }
__device__ __forceinline__ unsigned f2bf(float f) { unsigned u = __float_as_uint(f); return (u + 0x7fffu + ((u >> 16) & 1u)) >> 16; }
__device__ __forceinline__ float wave_sum(float v) {
#pragma unroll
    for (int o = 1; o < 64; o <<= 1) v += __shfl_xor(v, o);
    return v;
}
__device__ __forceinline__ int lane_id_v() { int l; asm volatile("v_mbcnt_lo_u32_b32 %0, -1, 0\n\tv_mbcnt_hi_u32_b32 %0, -1, %0" : "=v"(l)); return l; }
__device__ __forceinline__ float inv_freq(int j) { return __builtin_amdgcn_exp2f(-0.4152410118609203f * (float)j); }
__device__ __forceinline__ void sincos_rev(float ang, float& s, float& c) { const float r = ang * 0.15915494309189535f; s = __builtin_amdgcn_sinf(r); c = __builtin_amdgcn_cosf(r); }
__device__ __forceinline__ float silu(float z) { return z * __builtin_amdgcn_rcpf(1.f + __builtin_amdgcn_exp2f(-1.4426950408889634f * z)); }

namespace pg8 {
constexpr int BM = 256, BK = 64, HALF = 128, HTB = HALF * BK * 2, NXCD = 8, WGM = 8;
__host__ __device__ __forceinline__ int lds_byte(int r, int c) { const int st = (r >> 4) * 2 + (c >> 5), rr = r & 15, cc = c & 31, ob = rr * 64 + cc * 2; return st * 1024 + (ob ^ (((ob >> 9) & 1) << 5)); }
__host__ __device__ __forceinline__ void stage_rc(int b, int& R, int& C) { const int st = b / 1024, sb = b % 1024, swz = sb ^ (((sb >> 9) & 1) << 5); R = (st >> 1) * 16 + swz / 64; C = (st & 1) * 32 + (swz % 64) / 2; }
__host__ __device__ __forceinline__ int perm32(int rho) { const int n = rho >> 4, i = rho & 15; return 8 * (i >> 2) + 4 * n + (i & 3); }
struct Unit { int pm, pn; };
struct Gemm { const void* A; const void* Bt; int ldaB; int ldbB; int nt; };

struct Order {
    int nM, nN, nwg, G, c, nextra, mode;
    __device__ void init(int nM_, int nN_, int G_, int c_, int nextra_, int mode_ = 0) { nM = nM_; nN = nN_; nwg = nM * nN; G = G_; c = c_; nextra = nextra_; mode = mode_; }
    __device__ bool next(int i, Unit& u) const {
        const long L = (long)i * G + c; if (L >= nwg + nextra) return false;
        if (L >= nwg) { const int e = (int)(L - nwg); u.pm = nM; u.pn = e < 2 ? 8 + e : 12 + e; return true; }
        int wgid = (int)L; { const int q = nwg / NXCD, r = nwg % NXCD, xcd = wgid % NXCD, off = wgid / NXCD; wgid = (xcd < r ? xcd * (q + 1) : r * (q + 1) + (xcd - r) * q) + off; }
        const int nig = WGM * nN, gid = wgid / nig, fm = gid * WGM, gsz = (nM - fm) < WGM ? (nM - fm) : WGM;
        u.pm = fm + ((wgid % nig) % gsz); u.pn = (wgid % nig) / gsz;
        if (mode == 1) u.pn = u.pn < 4 ? 4 + u.pn : 10 + u.pn; else if (mode == 2) u.pn = u.pn < 4 ? u.pn : 4 + u.pn;
        return true;
    }
};

struct EpiU {
    static constexpr bool PERM = true;
    bf16_t* Qbuf; bf16_t* U; unsigned char* Kf8; const float* kna; const float* knb; LAS float* xch;
    __device__ __forceinline__ void init(f32x4 (&acc)[2][2][4][2], const Unit&, int, int, int, int) const {
#pragma unroll
        for (int a = 0; a < 2; ++a)
#pragma unroll
            for (int b = 0; b < 2; ++b)
#pragma unroll
                for (int m = 0; m < 4; ++m)
#pragma unroll
                    for (int n = 0; n < 2; ++n) acc[a][b][m][n] = (f32x4){0.f, 0.f, 0.f, 0.f};
    }
    __device__ __forceinline__ void operator()(const f32x4 (&acc)[2][2][4][2], const Unit& u, int wr, int wc, int fr, int fq) const {
        const int row0 = u.pm * BM + wr * 64 + fr;
        const bool isQ = u.pn < 8, isKa = (u.pn == 8), isKb = (u.pn >= 14 && u.pn < 18);
        bf16_t* const dst = isQ ? Qbuf : U; const int ldd = isQ ? NQ : NU, col0 = (isQ ? u.pn : u.pn - 8) * BM + wc * 32 + 8 * fq;
        if (!(isKa || isKb)) {
#pragma unroll
            for (int ai = 0; ai < 2; ++ai)
#pragma unroll
                for (int m = 0; m < 4; ++m) { bf16_t* rowp = dst + (size_t)(row0 + ai * HALF + m * 16) * ldd + col0;
#pragma unroll
                    for (int bj = 0; bj < 2; ++bj) { const f32x4 v0 = acc[ai][bj][m][0], v1 = acc[ai][bj][m][1];
                        u32x4 w; w.x = cvtpk(v0[0], v0[1]); w.y = cvtpk(v0[2], v0[3]); w.z = cvtpk(v1[0], v1[1]); w.w = cvtpk(v1[2], v1[3]);
                        *(u32x4*)(rowp + bj * HALF) = w; } }
            return;
        }
#pragma unroll
        for (int ai = 0; ai < 2; ++ai)
#pragma unroll
            for (int m = 0; m < 4; ++m)
#pragma unroll
                for (int bj = 0; bj < 2; ++bj) { const f32x4 v0 = acc[ai][bj][m][0], v1 = acc[ai][bj][m][1];
                    float ss = (v0[0] * v0[0] + v0[1] * v0[1]) + (v0[2] * v0[2] + v0[3] * v0[3]) + (v1[0] * v1[0] + v1[1] * v1[1]) + (v1[2] * v1[2] + v1[3] * v1[3]);
                    ss += __shfl_xor(ss, 16); ss += __shfl_xor(ss, 32);
                    if (fq == 0) xch[(ai * HALF + wr * 64 + m * 16 + fr) * 8 + bj * 4 + wc] = ss; }
        asm volatile("s_waitcnt lgkmcnt(0)" ::: "memory"); __builtin_amdgcn_s_barrier(); asm volatile("" ::: "memory");
        const int e0 = isKa ? 64 * (wc >> 1) + 16 * (wc & 1) + 4 * fq : 32 * wc + 8 * fq;
        const float* gp = isKa ? kna : knb;
        const f32x4 g0 = *(const f32x4*)(gp + e0), g1 = *(const f32x4*)(gp + e0 + (isKa ? 32 : 4));
        float ifr[4];
#pragma unroll
        for (int i = 0; i < 4; ++i) ifr[i] = inv_freq(16 * (wc & 1) + 4 * fq + i);
#pragma unroll
        for (int ai = 0; ai < 2; ++ai)
#pragma unroll
            for (int m = 0; m < 4; ++m) { const int rl = ai * HALF + wr * 64 + m * 16 + fr, row = u.pm * BM + rl;
                float sn[4], cs[4];
                if (isKa) { float rowpos, colpos;
                    if (row < NTOK) { const int t = row < 8192 ? row : ((row - 8192) & 2047); rowpos = (float)(t >> 6); colpos = (float)(t & 63); } else { rowpos = -1.f; colpos = (float)(row - META_ROW0); }
                    const float pos = (wc >> 1) ? colpos : rowpos;
#pragma unroll
                    for (int i = 0; i < 4; ++i) sincos_rev(pos * ifr[i], sn[i], cs[i]); }
                bf16_t* rowp = U + (size_t)row * NU + col0;
#pragma unroll
                for (int bj = 0; bj < 2; ++bj) { const f32x4 t = *(const LAS f32x4*)(xch + rl * 8 + bj * 4);
                    const float rs = __builtin_amdgcn_rsqf(((t[0] + t[1]) + (t[2] + t[3])) * (1.f / 128.f) + EPS);
                    f32x4 v0 = acc[ai][bj][m][0] * rs * g0, v1 = acc[ai][bj][m][1] * rs * g1;
                    if (isKa) {
#pragma unroll
                        for (int i = 0; i < 4; ++i) { const float x1 = v0[i], x2 = v1[i]; v0[i] = x1 * cs[i] - x2 * sn[i]; v1[i] = x1 * sn[i] + x2 * cs[i]; } }
                    if (isKa) {
                        u32x2 w8; w8.x = pk4_fp8(v0[0], v0[1], v0[2], v0[3]); w8.y = pk4_fp8(v1[0], v1[1], v1[2], v1[3]);
                        *(u32x2*)(Kf8 + (size_t)row * 256 + bj * 128 + (fq & 1) * 64 + (2 * wc + (fq >> 1)) * 8) = w8;
                    } else {
                    u32x4 w; w.x = cvtpk(v0[0], v0[1]); w.y = cvtpk(v0[2], v0[3]); w.z = cvtpk(v1[0], v1[1]); w.w = cvtpk(v1[2], v1[3]);
                    *(u32x4*)(rowp + bj * HALF) = w; } } }
    }
};
struct EpiOut {
    static constexpr bool PERM = false;
    const float* xp; const float* xs; float* out;
    __device__ __forceinline__ void init(f32x4 (&acc)[2][2][4][2], const Unit& u, int wr, int wc, int fr, int fq) const {
        const int row0 = u.pm * BM + wr * 64 + fr, col0 = u.pn * BM + wc * 32 + 4 * fq;
#pragma unroll
        for (int ai = 0; ai < 2; ++ai)
#pragma unroll
            for (int m = 0; m < 4; ++m) { const int row = row0 + ai * HALF + m * 16;
                const float* xr = (row < 8192 ? xp + (size_t)row * DM : xs + (size_t)(row - 8192) * DM) + col0;
#pragma unroll
                for (int bj = 0; bj < 2; ++bj)
#pragma unroll
                    for (int n = 0; n < 2; ++n) acc[ai][bj][m][n] = *(const f32x4*)(xr + bj * HALF + n * 16); }
    }
    __device__ __forceinline__ void operator()(const f32x4 (&acc)[2][2][4][2], const Unit& u, int wr, int wc, int fr, int fq) const {
        const int row0 = u.pm * BM + wr * 64 + fr, col0 = u.pn * BM + wc * 32 + 4 * fq;
#pragma unroll
        for (int ai = 0; ai < 2; ++ai)
#pragma unroll
            for (int m = 0; m < 4; ++m) { float* orow = out + (size_t)(row0 + ai * HALF + m * 16) * DM + col0;
#pragma unroll
                for (int bj = 0; bj < 2; ++bj)
#pragma unroll
                    for (int n = 0; n < 2; ++n) *(f32x4*)(orow + bj * HALF + n * 16) = acc[ai][bj][m][n]; }
    }
};

template <class Epi, class Sched, bool ALIGN_EPI, bool SP2, bool FP8 = false>
__device__ __forceinline__ void gemm_phase(LAS unsigned char* lds, const Gemm g, const Sched& S, const Epi& E, int wid, f32x4 (&acc)[2][2][4][2], bool preinit) {
    const int lane = lane_id_v(), tid = wid * 64 + lane, wr = wid >> 2, wc = wid & 3, fr = lane & 15, fq = lane >> 4;
    const int nt = g.nt, ldaB = g.ldaB, ldbB = g.ldbB;
    unsigned voffA[2], voffB[2];
#pragma unroll
    for (int i = 0; i < 2; ++i) { int R, C; stage_rc(tid * 16 + i * 8192, R, C); const int Rb = Epi::PERM ? ((R & ~31) + perm32(R & 31)) : R;
        voffA[i] = (unsigned)(R * ldaB + C * 2); voffB[i] = (unsigned)(Rb * ldbB + C * 2); }
    const size_t kstep = (size_t)(BK * 2);
    const size_t hstepA = (size_t)HALF * ldaB, hstepB = (size_t)HALF * ldbB;
    const size_t tstepA = 2 * hstepA, tstepB = 2 * hstepB;
    const unsigned ldsw = (unsigned)wid * 1024u;
    const int aoff = lds_byte(wr * 64 + fr, fq * 8), boff = lds_byte(wc * 32 + fr, fq * 8);
#define PG8_SA(b, h) (((b) * 2 + (h)) * HTB)
#define PG8_SB(b, h) ((4 + (b) * 2 + (h)) * HTB)
#define PG8_STAGE(bufoff, gbase, voff) do { _Pragma("unroll") for (int _i = 0; _i < 2; ++_i) \
        __builtin_amdgcn_global_load_lds((const unsigned*)((const char*)(gbase) + (voff)[_i]), (LAS unsigned*)(lds + (bufoff) + ldsw + _i * 8192), 16, 0, 0); } while (0)
#define PG8_LDA(dst, b, h) do { _Pragma("unroll") for (int m = 0; m < 4; ++m) _Pragma("unroll") for (int k = 0; k < 2; ++k) dst[m].k[k] = *(const LAS bf16x8*)(lds + PG8_SA(b, h) + aoff + m * 2048 + k * 1024); } while (0)
#define PG8_LDB(dst, b, h) do { _Pragma("unroll") for (int n = 0; n < 2; ++n) _Pragma("unroll") for (int k = 0; k < 2; ++k) dst[n].k[k] = *(const LAS bf16x8*)(lds + PG8_SB(b, h) + boff + n * 2048 + k * 1024); } while (0)
#define PG8_MMA(ai, bj, At, Bt) do { __builtin_amdgcn_s_setprio(1); if constexpr (FP8) { \
        _Pragma("unroll") for (int m = 0; m < 4; ++m) _Pragma("unroll") for (int n = 0; n < 2; ++n) \
            asm volatile("v_mfma_scale_f32_16x16x128_f8f6f4 %0, %1, %2, %0, %3, %4 op_sel_hi:[0,0,0]" : "+v"(acc[ai][bj][m][n]) : "v"(Bt[n].v), "v"(At[m].v), "v"(sc_w), "v"(sc_x)); \
      } else { _Pragma("unroll") for (int m = 0; m < 4; ++m) _Pragma("unroll") for (int n = 0; n < 2; ++n) _Pragma("unroll") for (int k = 0; k < 2; ++k) \
        acc[ai][bj][m][n] = __builtin_amdgcn_mfma_f32_16x16x32_bf16(Bt[n].k[k], At[m].k[k], acc[ai][bj][m][n], 0, 0, 0); } __builtin_amdgcn_s_setprio(0); } while (0)
#define PG8_WAIT_V(n) asm volatile("s_waitcnt vmcnt(" #n ")" ::: "memory")
#define PG8_WAIT_L(n) asm volatile("s_waitcnt lgkmcnt(" #n ")" ::: "memory")
#define PG8_BAR __builtin_amdgcn_s_barrier()
#define PG8_SCHED __builtin_amdgcn_sched_barrier(0)
    Unit cur, nxt; int ui = 0;
    if (!S.next(0, cur)) return;
    if (!preinit) E.init(acc, cur, wr, wc, fr, fq);
    union FragU { v8i v; bf16x8 k[2]; };
    FragU At[4], B0[2], B1[2];
    const int sc_w = 0x79797979, sc_x = 0x7F7F7F7F;
    const char* cA = (const char*)g.A + (size_t)cur.pm * tstepA; const char* cB = (const char*)g.Bt + (size_t)cur.pn * tstepB;
    if constexpr (SP2) {
        PG8_STAGE(PG8_SB(0, 0), cB, voffB); PG8_STAGE(PG8_SB(0, 1), cB + hstepB, voffB); PG8_STAGE(PG8_SA(0, 0), cA, voffA); PG8_STAGE(PG8_SA(0, 1), cA + hstepA, voffA);
        if (wr == 1) PG8_BAR;
        PG8_WAIT_V(2); PG8_BAR;
        PG8_STAGE(PG8_SB(1, 0), cB + kstep, voffB); PG8_STAGE(PG8_SA(1, 0), cA + kstep, voffA); PG8_STAGE(PG8_SB(1, 1), cB + hstepB + kstep, voffB);
        PG8_WAIT_V(6); PG8_BAR;
    } else {
        PG8_STAGE(PG8_SB(0, 0), cB, voffB); PG8_STAGE(PG8_SA(0, 0), cA, voffA); PG8_STAGE(PG8_SB(0, 1), cB + hstepB, voffB); PG8_STAGE(PG8_SA(0, 1), cA + hstepA, voffA);
        if (wr == 1) PG8_BAR;
        PG8_WAIT_V(4); PG8_BAR;
        PG8_STAGE(PG8_SB(1, 0), cB + kstep, voffB); PG8_STAGE(PG8_SA(1, 0), cA + kstep, voffA); PG8_STAGE(PG8_SB(1, 1), cB + hstepB + kstep, voffB);
        PG8_WAIT_V(6); PG8_BAR;
    }
    for (;;) {
        const bool has_next = S.next(ui + 1, nxt);
        const char* nA = has_next ? (const char*)g.A + (size_t)nxt.pm * tstepA : cA; const char* nB = has_next ? (const char*)g.Bt + (size_t)nxt.pn * tstepB : cB;
        for (int t = 0; t < nt; t += 2) {
            const bool last = (t == nt - 2);
            const char* a1 = cA + (size_t)(t + 1) * kstep;
            const char* a2 = last ? nA : cA + (size_t)(t + 2) * kstep; const char* b2 = last ? nB : cB + (size_t)(t + 2) * kstep;
            const char* a3 = a2 + kstep; const char* b3 = b2 + kstep;
            if constexpr (SP2) {
            PG8_LDB(B0, 0, 0); PG8_LDB(B1, 0, 1); PG8_SCHED; PG8_LDA(At, 0, 0); PG8_STAGE(PG8_SA(1, 1), a1 + hstepA, voffA);
            PG8_WAIT_V(8); PG8_WAIT_L(0); PG8_BAR; PG8_MMA(0, 0, At, B0); PG8_MMA(0, 1, At, B1); PG8_BAR; PG8_SCHED;
            PG8_LDA(At, 0, 1); PG8_STAGE(PG8_SB(0, 0), b2, voffB); PG8_STAGE(PG8_SB(0, 1), b2 + hstepB, voffB); PG8_STAGE(PG8_SA(0, 0), a2, voffA);
            PG8_WAIT_V(8); PG8_WAIT_L(0); PG8_BAR; PG8_MMA(1, 0, At, B0); PG8_MMA(1, 1, At, B1); PG8_BAR; PG8_SCHED;
            PG8_LDB(B0, 1, 0); PG8_LDB(B1, 1, 1); PG8_SCHED; PG8_LDA(At, 1, 0); PG8_STAGE(PG8_SA(0, 1), a2 + hstepA, voffA);
            PG8_WAIT_V(8); PG8_WAIT_L(0); PG8_BAR; PG8_MMA(0, 0, At, B0); PG8_MMA(0, 1, At, B1); PG8_BAR; PG8_SCHED;
            PG8_LDA(At, 1, 1); PG8_STAGE(PG8_SB(1, 0), b3, voffB); PG8_STAGE(PG8_SB(1, 1), b3 + hstepB, voffB); PG8_STAGE(PG8_SA(1, 0), a3, voffA);
            PG8_WAIT_V(8); PG8_WAIT_L(0); PG8_BAR; PG8_MMA(1, 0, At, B0); PG8_MMA(1, 1, At, B1); PG8_BAR; PG8_SCHED;
            } else {
            PG8_LDB(B0, 0, 0); PG8_SCHED; PG8_LDA(At, 0, 0); PG8_STAGE(PG8_SA(1, 1), a1 + hstepA, voffA);
            PG8_WAIT_L(8); PG8_BAR; PG8_WAIT_L(0); PG8_MMA(0, 0, At, B0); PG8_BAR; PG8_SCHED;
            PG8_LDB(B1, 0, 1); PG8_STAGE(PG8_SB(0, 0), b2, voffB);
            PG8_BAR; PG8_WAIT_L(0); PG8_MMA(0, 1, At, B1); PG8_BAR;
            PG8_LDA(At, 0, 1); PG8_STAGE(PG8_SA(0, 0), a2, voffA);
            PG8_BAR; PG8_WAIT_L(0); PG8_MMA(1, 0, At, B0); PG8_BAR; PG8_SCHED;
            PG8_STAGE(PG8_SB(0, 1), b2 + hstepB, voffB);
            PG8_WAIT_V(6); PG8_BAR; PG8_MMA(1, 1, At, B1); PG8_BAR;
            PG8_LDB(B0, 1, 0); PG8_SCHED; PG8_LDA(At, 1, 0); PG8_STAGE(PG8_SA(0, 1), a2 + hstepA, voffA);
            PG8_WAIT_L(8); PG8_BAR; PG8_WAIT_L(0); PG8_MMA(0, 0, At, B0); PG8_BAR; PG8_SCHED;
            PG8_LDB(B1, 1, 1); PG8_STAGE(PG8_SB(1, 0), b3, voffB);
            PG8_BAR; PG8_WAIT_L(0); PG8_MMA(0, 1, At, B1); PG8_BAR;
            PG8_LDA(At, 1, 1); PG8_STAGE(PG8_SA(1, 0), a3, voffA);
            PG8_BAR; PG8_WAIT_L(0); PG8_MMA(1, 0, At, B0); PG8_BAR; PG8_SCHED;
            PG8_STAGE(PG8_SB(1, 1), b3 + hstepB, voffB);
            PG8_WAIT_V(6); PG8_BAR; PG8_MMA(1, 1, At, B1); PG8_BAR;
            }
        }
        if constexpr (ALIGN_EPI) { if (wr == 0) PG8_BAR; }
        if constexpr (FP8) asm volatile("s_nop 15\n\ts_nop 15" ::: "memory");
        E(acc, cur, wr, wc, fr, fq);
        if (!has_next) break;
        E.init(acc, nxt, wr, wc, fr, fq);
        cur = nxt; cA = nA; cB = nB; ++ui;
        if constexpr (ALIGN_EPI) { if (wr == 1) PG8_BAR; }
    }
    PG8_WAIT_V(0);
    if constexpr (!ALIGN_EPI) { if (wr == 0) PG8_BAR; }
    PG8_BAR;
#undef PG8_SA
#undef PG8_SB
#undef PG8_STAGE
#undef PG8_LDA
#undef PG8_LDB
#undef PG8_MMA
#undef PG8_WAIT_V
#undef PG8_WAIT_L
#undef PG8_BAR
#undef PG8_SCHED
}
}

namespace att {
constexpr int D = 128, NW = 8, QBLK = 32, KVBLK = 64;
constexpr float SCALE = 0.088388347648318440f, INV_SCALE = 11.313708498984761f;
constexpr float THR = 8.f;
constexpr float NEG = -1e30f;
constexpr int LD = NU;
constexpr int SHM_V = KVBLK * D * 2, SHM_K = KVBLK * D * 2;
#define KSWZ(row, colB) ((row) * 256 + ((colB) ^ (((row) & 7) << 4)))
#define SBAR() __builtin_amdgcn_sched_barrier(0)
__device__ __forceinline__ int crow(int r, int hi) { return (r & 3) + 8 * (r >> 2) + 4 * hi; }

__device__ __forceinline__ void partialSM(f32x16& p0, f32x16& p1, float& m_reg, float& mn, float& alpha) {
  constexpr float C = SCALE * 1.4426950408889634f;
  float pmax = p0[0];
#pragma unroll
  for (int r = 1; r < 16; ++r) pmax = fmaxf(pmax, p0[r]);
#pragma unroll
  for (int r = 0; r < 16; ++r) pmax = fmaxf(pmax, p1[r]);
  { auto rr = __builtin_amdgcn_permlane32_swap(__float_as_uint(pmax), __float_as_uint(pmax), false, false);
    pmax = fmaxf(__uint_as_float(rr[0]), __uint_as_float(rr[1])); }
  if (__builtin_expect(__all(pmax - m_reg <= THR / SCALE), 1)) { mn = m_reg; alpha = 1.f; }
  else { mn = fmaxf(m_reg, pmax); alpha = __builtin_amdgcn_exp2f((m_reg - mn) * C); m_reg = mn; }
  float mnC = -mn * C;
#pragma unroll
  for (int r = 0; r < 16; ++r) p0[r] = fmaf(p0[r], C, mnC);
#pragma unroll
  for (int r = 0; r < 16; ++r) p1[r] = fmaf(p1[r], C, mnC);
#pragma unroll
  for (int r = 0; r < 16; ++r) p0[r] = __builtin_amdgcn_exp2f(p0[r]);
}
__device__ __forceinline__ void partialSM_fix(f32x16& p0, f32x16& p1, float negBC) {
  constexpr float C = SCALE * 1.4426950408889634f;
#pragma unroll
  for (int r = 0; r < 16; ++r) p0[r] = fmaf(p0[r], C, negBC);
#pragma unroll
  for (int r = 0; r < 16; ++r) p1[r] = fmaf(p1[r], C, negBC);
#pragma unroll
  for (int r = 0; r < 16; ++r) p0[r] = __builtin_amdgcn_exp2f(p0[r]);
}
__device__ __forceinline__ void finishSM(f32x16& p0, f32x16& p1, float alpha, float& l_reg, bf16x8& pa0, bf16x8& pa1, bf16x8& pa2, bf16x8& pa3) {
#pragma unroll
  for (int r = 0; r < 16; ++r) p1[r] = __builtin_amdgcn_exp2f(p1[r]);
  float ps = 0;
#pragma unroll
  for (int r = 0; r < 16; ++r) ps += p0[r];
#pragma unroll
  for (int r = 0; r < 16; ++r) ps += p1[r];
  { auto rr = __builtin_amdgcn_permlane32_swap(__float_as_uint(ps), __float_as_uint(ps), false, false);
    ps = __uint_as_float(rr[0]) + __uint_as_float(rr[1]); }
  l_reg = l_reg * alpha + ps;
#define PK4(P, BASE, OUT) do { unsigned a0 = cvtpk(P[BASE + 0], P[BASE + 1]), a1 = cvtpk(P[BASE + 2], P[BASE + 3]);   \
    unsigned b0 = cvtpk(P[BASE + 4], P[BASE + 5]), b1 = cvtpk(P[BASE + 6], P[BASE + 7]);                              \
    auto r0 = __builtin_amdgcn_permlane32_swap(a0, b0, false, false); auto r1 = __builtin_amdgcn_permlane32_swap(a1, b1, false, false); \
    u32x4 w = {r0[0], r1[0], r0[1], r1[1]}; OUT = *reinterpret_cast<bf16x8*>(&w); } while (0)
  PK4(p0, 0, pa0); PK4(p0, 8, pa1); PK4(p1, 0, pa2); PK4(p1, 8, pa3);
#undef PK4
}
__device__ __forceinline__ void qkt(f32x16& p0, f32x16& p1, const char* Ks, const bf16x8* qr, int r32, int hi) {
  p0 = f32x16{}; p1 = f32x16{};
#pragma unroll
  for (int d0 = 0; d0 < 8; ++d0) { int cb = (d0 * 16 + hi * 8) * 2;
    bf16x8 b0 = *reinterpret_cast<const bf16x8*>(Ks + KSWZ(r32, cb));
    bf16x8 b1 = *reinterpret_cast<const bf16x8*>(Ks + KSWZ(32 + r32, cb));
    p0 = __builtin_amdgcn_mfma_f32_32x32x16_bf16(b0, qr[d0], p0, 0, 0, 0);
    p1 = __builtin_amdgcn_mfma_f32_32x32x16_bf16(b1, qr[d0], p1, 0, 0, 0); }
}
__device__ __forceinline__ int v_st(int k, int c) { const int kk = (k & ~0xC) | ((k & 4) << 1) | ((k & 8) >> 1); return ((kk >> 3) * 4 + (c >> 5)) * 512 + ((kk & 7) * 32 + (c & 31)) * 2; }
__device__ __forceinline__ int v_rd_base(int lane) { return ((lane & 3) << 3) | (((lane >> 2) & 3) << 6) | (((lane >> 4) & 1) << 5) | (((lane >> 5) & 1) << 8); }
constexpr int v_rd_off(int d0, int ks, int half) { return d0 * 512 + ks * 4096 + half * 2048; }
template <int OFF> __device__ __forceinline__ s16x4 tr_read(int vb) {
  s16x4 r; asm volatile("ds_read_b64_tr_b16 %0, %1 offset:%2" : "=&v"(r) : "v"(vb), "i"(OFF) : "memory"); return r;
}
template <int D0> __device__ __forceinline__ void pv_one(f32x16& od, int vb, bf16x8 pa0, bf16x8 pa1, bf16x8 pa2, bf16x8 pa3) {
  const s16x4 l0 = tr_read<v_rd_off(D0, 0, 0)>(vb), h0 = tr_read<v_rd_off(D0, 0, 1)>(vb), l1 = tr_read<v_rd_off(D0, 1, 0)>(vb), h1 = tr_read<v_rd_off(D0, 1, 1)>(vb);
  const s16x4 l2 = tr_read<v_rd_off(D0, 2, 0)>(vb), h2 = tr_read<v_rd_off(D0, 2, 1)>(vb), l3 = tr_read<v_rd_off(D0, 3, 0)>(vb), h3 = tr_read<v_rd_off(D0, 3, 1)>(vb);
  asm volatile("s_waitcnt lgkmcnt(0)" ::: "memory"); SBAR();
#define PK(L, H) (bf16x8){L[0], L[1], L[2], L[3], H[0], H[1], H[2], H[3]}
  od = __builtin_amdgcn_mfma_f32_32x32x16_bf16(pa0, PK(l0, h0), od, 0, 0, 0);
  od = __builtin_amdgcn_mfma_f32_32x32x16_bf16(pa1, PK(l1, h1), od, 0, 0, 0);
  od = __builtin_amdgcn_mfma_f32_32x32x16_bf16(pa2, PK(l2, h2), od, 0, 0, 0);
  od = __builtin_amdgcn_mfma_f32_32x32x16_bf16(pa3, PK(l3, h3), od, 0, 0, 0);
#undef PK
}
__device__ __forceinline__ void pv_d0(f32x16* o, int vb, bf16x8 pa0, bf16x8 pa1, bf16x8 pa2, bf16x8 pa3) {
  pv_one<0>(o[0], vb, pa0, pa1, pa2, pa3); pv_one<1>(o[1], vb, pa0, pa1, pa2, pa3); pv_one<2>(o[2], vb, pa0, pa1, pa2, pa3); pv_one<3>(o[3], vb, pa0, pa1, pa2, pa3);
}

#define PV_RD(D0, A0, A1, A2, A3, A4, A5, A6, A7) do { A0 = tr_read<v_rd_off(D0, 0, 0)>(vb); A1 = tr_read<v_rd_off(D0, 0, 1)>(vb); A2 = tr_read<v_rd_off(D0, 1, 0)>(vb); A3 = tr_read<v_rd_off(D0, 1, 1)>(vb); \
    A4 = tr_read<v_rd_off(D0, 2, 0)>(vb); A5 = tr_read<v_rd_off(D0, 2, 1)>(vb); A6 = tr_read<v_rd_off(D0, 3, 0)>(vb); A7 = tr_read<v_rd_off(D0, 3, 1)>(vb); } while (0)
#define PV_PK(L, H) (bf16x8){L[0], L[1], L[2], L[3], H[0], H[1], H[2], H[3]}
#define PV_MM(OD, A0, A1, A2, A3, A4, A5, A6, A7) do { OD = __builtin_amdgcn_mfma_f32_32x32x16_bf16(pa0, PV_PK(A0, A1), OD, 0, 0, 0); OD = __builtin_amdgcn_mfma_f32_32x32x16_bf16(pa1, PV_PK(A2, A3), OD, 0, 0, 0); \
    OD = __builtin_amdgcn_mfma_f32_32x32x16_bf16(pa2, PV_PK(A4, A5), OD, 0, 0, 0); OD = __builtin_amdgcn_mfma_f32_32x32x16_bf16(pa3, PV_PK(A6, A7), OD, 0, 0, 0); } while (0)
__device__ __forceinline__ void pv_pipe(f32x16* o, int vb, bf16x8 pa0, bf16x8 pa1, bf16x8 pa2, bf16x8 pa3) {
  s16x4 a0, a1, a2, a3, a4, a5, a6, a7, b0, b1, b2, b3, b4, b5, b6, b7;
  PV_RD(0, a0, a1, a2, a3, a4, a5, a6, a7);
  PV_RD(1, b0, b1, b2, b3, b4, b5, b6, b7);
  asm volatile("s_waitcnt lgkmcnt(8)" ::: "memory"); SBAR();
  PV_MM(o[0], a0, a1, a2, a3, a4, a5, a6, a7);
  PV_RD(2, a0, a1, a2, a3, a4, a5, a6, a7);
  asm volatile("s_waitcnt lgkmcnt(8)" ::: "memory"); SBAR();
  PV_MM(o[1], b0, b1, b2, b3, b4, b5, b6, b7);
  PV_RD(3, b0, b1, b2, b3, b4, b5, b6, b7);
  asm volatile("s_waitcnt lgkmcnt(8)" ::: "memory"); SBAR();
  PV_MM(o[2], a0, a1, a2, a3, a4, a5, a6, a7);
  asm volatile("s_waitcnt lgkmcnt(0)" ::: "memory"); SBAR();
  PV_MM(o[3], b0, b1, b2, b3, b4, b5, b6, b7);
}

template <int OFF> __device__ __forceinline__ bf16x8 k_read(int addr) { bf16x8 r; asm volatile("ds_read_b128 %0, %1 offset:%2" : "=&v"(r) : "v"(addr), "i"(OFF) : "memory"); return r; }
#define K_RD(D0, X0, X1) do { X0 = k_read<((D0) >> 2) * 128>(kb[(D0) & 3]); X1 = k_read<((D0) >> 2) * 128 + 8192>(kb[(D0) & 3]); } while (0)
#define K_MM(D0, X0, X1) do { p0 = __builtin_amdgcn_mfma_f32_32x32x16_bf16(X0, qr[D0], p0, 0, 0, 0); p1 = __builtin_amdgcn_mfma_f32_32x32x16_bf16(X1, qr[D0], p1, 0, 0, 0); } while (0)
#define LGKM(n) asm volatile("s_waitcnt lgkmcnt(" #n ")" ::: "memory")
__device__ __forceinline__ void qkt_pipe(f32x16& p0, f32x16& p1, const int* kb, const bf16x8* qr) {
  bf16x8 x0, x1, y0, y1, z0, z1;
  K_RD(0, x0, x1); K_RD(1, y0, y1); K_RD(2, z0, z1);
  p0 = f32x16{}; p1 = f32x16{};
  LGKM(4); SBAR(); K_MM(0, x0, x1); K_RD(3, x0, x1);
  LGKM(4); SBAR(); K_MM(1, y0, y1); K_RD(4, y0, y1);
  LGKM(4); SBAR(); K_MM(2, z0, z1); K_RD(5, z0, z1);
  LGKM(4); SBAR(); K_MM(3, x0, x1); K_RD(6, x0, x1);
  LGKM(4); SBAR(); K_MM(4, y0, y1); K_RD(7, y0, y1);
  LGKM(4); SBAR(); K_MM(5, z0, z1);
  LGKM(2); SBAR(); K_MM(6, x0, x1);
  LGKM(0); SBAR(); K_MM(7, y0, y1);
}

template <bool ROPE>
__device__ __forceinline__ void q_prologue(bf16x8* qr, v8i* q8, const bf16_t* Qw, const float* __restrict__ gain, int hi, float rowpos, float colpos) {
  float qf[8][8]; float ss = 0.f;
#pragma unroll
  for (int d0 = 0; d0 < 8; ++d0) { const u32x4 v = *reinterpret_cast<const u32x4*>(Qw + d0 * 16);
    qf[d0][0] = bflo(v.x); qf[d0][1] = bfhi(v.x); qf[d0][2] = bflo(v.y); qf[d0][3] = bfhi(v.y); qf[d0][4] = bflo(v.z); qf[d0][5] = bfhi(v.z); qf[d0][6] = bflo(v.w); qf[d0][7] = bfhi(v.w);
#pragma unroll
    for (int i = 0; i < 8; ++i) ss = fmaf(qf[d0][i], qf[d0][i], ss); }
  { auto rr = __builtin_amdgcn_permlane32_swap(__float_as_uint(ss), __float_as_uint(ss), false, false); ss = __uint_as_float(rr[0]) + __uint_as_float(rr[1]); }
  const float rs = __builtin_amdgcn_rsqf(ss * (1.f / 128.f) + EPS);
#pragma unroll
  for (int d0 = 0; d0 < 8; ++d0) {
    const int base = ROPE ? 64 * (d0 >> 2) + 16 * ((d0 >> 1) & 1) + 8 * (d0 & 1) + 4 * hi : d0 * 16 + hi * 8;
    const f32x4 g0 = *reinterpret_cast<const f32x4*>(gain + base), g1 = *reinterpret_cast<const f32x4*>(gain + base + (ROPE ? 32 : 4));
#pragma unroll
    for (int i = 0; i < 4; ++i) { qf[d0][i] *= rs * g0[i]; qf[d0][4 + i] *= rs * g1[i]; } }
  if constexpr (ROPE) {
#pragma unroll
    for (int d0 = 0; d0 < 8; ++d0) { const float pos = (d0 >> 2) ? colpos : rowpos;
#pragma unroll
      for (int i = 0; i < 4; ++i) { const int j = 16 * ((d0 >> 1) & 1) + 8 * (d0 & 1) + 4 * hi + i; float sn, c; sincos_rev(pos * inv_freq(j), sn, c);
        const float x1 = qf[d0][i], x2 = qf[d0][i + 4];
        qf[d0][i] = x1 * c - x2 * sn; qf[d0][i + 4] = x1 * sn + x2 * c; } }
  }
  if constexpr (ROPE) {
    constexpr float QS = SCALE * 1.4426950408889634f * 8.f;
#pragma unroll
    for (int kk = 0; kk < 2; ++kk)
#pragma unroll
      for (int c = 0; c < 4; ++c) { q8[kk][2 * c] = (int)pk4_fp8(qf[4 * kk + c][0] * QS, qf[4 * kk + c][1] * QS, qf[4 * kk + c][2] * QS, qf[4 * kk + c][3] * QS); q8[kk][2 * c + 1] = (int)pk4_fp8(qf[4 * kk + c][4] * QS, qf[4 * kk + c][5] * QS, qf[4 * kk + c][6] * QS, qf[4 * kk + c][7] * QS); }
  } else {
#pragma unroll
  for (int d0 = 0; d0 < 8; ++d0) { u32x4 w = {cvtpk(qf[d0][0], qf[d0][1]), cvtpk(qf[d0][2], qf[d0][3]), cvtpk(qf[d0][4], qf[d0][5]), cvtpk(qf[d0][6], qf[d0][7])}; qr[d0] = *reinterpret_cast<bf16x8*>(&w); }
  }
}

__device__ __forceinline__ void o_epilogue(const f32x16* o, float l_reg, float* li_l, bf16_t* Ow, const bf16_t* Zw, int r32, int hi) {
  if (hi == 0) li_l[r32] = l_reg; asm volatile("s_waitcnt lgkmcnt(0)" ::: "memory");
  const unsigned zoff = (unsigned)(4 * hi * LD + r32), ooff = (unsigned)(4 * hi * NQ + r32);
#pragma unroll
  for (int r = 0; r < 16; ++r) { const int rc = (r & 3) + 8 * (r >> 2); const float rl = __builtin_amdgcn_rcpf(li_l[rc + 4 * hi]);
    const bf16_t* zr = Zw + (size_t)rc * LD; bf16_t* orw = Ow + (size_t)rc * NQ;
#pragma unroll
    for (int d0 = 0; d0 < 4; ++d0) { const float z = bf2f(zr[zoff + d0 * 32]); orw[ooff + d0 * 32] = (bf16_t)f2bf(o[d0][r] * rl * silu(z)); } }
}

constexpr int SHM_K8 = KVBLK * 128;
__device__ __forceinline__ void qkt8(f32x16& p0, f32x16& p1, const char* Ks, const v8i* q8, int r32, int hi) {
  p0 = f32x16{}; p1 = f32x16{};
  const int sw = (r32 >> 1) & 7; const char* rowp = Ks + r32 * 128;
#pragma unroll
  for (int kk = 0; kk < 2; ++kk) {
    const int c0 = ((4 * hi + 2 * kk) ^ sw) << 4, c1 = ((4 * hi + 2 * kk + 1) ^ sw) << 4;
    const u32x4 a0 = *reinterpret_cast<const u32x4*>(rowp + c0), a1 = *reinterpret_cast<const u32x4*>(rowp + c1);
    const u32x4 b0 = *reinterpret_cast<const u32x4*>(rowp + 4096 + c0), b1 = *reinterpret_cast<const u32x4*>(rowp + 4096 + c1);
    const v8i ka = {(int)a0.x, (int)a0.y, (int)a0.z, (int)a0.w, (int)a1.x, (int)a1.y, (int)a1.z, (int)a1.w};
    const v8i kb = {(int)b0.x, (int)b0.y, (int)b0.z, (int)b0.w, (int)b1.x, (int)b1.y, (int)b1.z, (int)b1.w};
    p0 = __builtin_amdgcn_mfma_scale_f32_32x32x64_f8f6f4(ka, q8[kk], p0, 0, 0, 0, 0x7F7F7F7F, 0, 0x7C7C7C7C);
    p1 = __builtin_amdgcn_mfma_scale_f32_32x32x64_f8f6f4(kb, q8[kk], p1, 0, 0, 0, 0x7F7F7F7F, 0, 0x7C7C7C7C); }
}

constexpr int NSLOT = 4, RING_V = NSLOT * SHM_K;
__device__ __forceinline__ void attnA_item(const bf16_t* Qb, bf16_t* Ob, const bf16_t* __restrict__ Zb, const unsigned char* __restrict__ Kmeta, const bf16_t* __restrict__ Vmeta,
                                           const unsigned char* __restrict__ Kreal, const bf16_t* __restrict__ Vreal, int S, int t0, const float* __restrict__ gain, float negBC, char* lds, float* wsbase, int wid) {
  const int lane = lane_id_v(), r32 = lane & 31, hi = lane >> 5;
  float* ws = wsbase + wid * 64; float* li_l = ws; float* al_l = ws + 32;
  float l_reg = 0; f32x16 o[4] = {}; v8i q8[2];
  unsigned koff, voff[2];
  { const int row = wid * 8 + (lane >> 3), c = (lane & 7) ^ ((row >> 1) & 7); koff = (unsigned)(row * 256 + c * 16); }
#pragma unroll
  for (int i = 0; i < 2; ++i) { const int b = (wid * 2 + i) * 1024 + lane * 16;
    { const int sub = b >> 9, w = b & 511, kk = (sub >> 2) * 8 + (w >> 6), k = (kk & ~0xC) | ((kk & 4) << 1) | ((kk & 8) >> 1), c = (sub & 3) * 32 + ((w & 63) >> 1); voff[i] = (unsigned)(k * LD * 2 + c * 2); } }
  const int NT = 1 + S / KVBLK;
  LAS unsigned char* ldsl = (LAS unsigned char*)lds;
#define DLOAD(tt) do { const int _t = (tt) < NT ? (tt) : NT - 1; const int _s = (tt) & (NSLOT - 1); \
    const char* _k = (const char*)(_t == 0 ? Kmeta : Kreal + (size_t)(_t - 1) * KVBLK * 256); const char* _v = (const char*)(_t == 0 ? Vmeta : Vreal + (size_t)(_t - 1) * KVBLK * LD); \
    __builtin_amdgcn_global_load_lds((const unsigned*)(_k + koff), (LAS unsigned*)(ldsl + _s * SHM_K8 + wid * 1024), 16, 0, 0); \
    _Pragma("unroll") for (int _i = 0; _i < 2; ++_i) \
      __builtin_amdgcn_global_load_lds((const unsigned*)(_v + voff[_i]), (LAS unsigned*)(ldsl + RING_V + _s * SHM_V + (wid * 2 + _i) * 1024), 16, 0, 0); } while (0)
#define KSLOT(t) (lds + ((t) & (NSLOT - 1)) * SHM_K8)
#define VSLOT(t) (vb0 + ((t) & (NSLOT - 1)) * SHM_V)
#define LANDED() do { asm volatile("s_waitcnt vmcnt(4)" ::: "memory"); __builtin_amdgcn_s_barrier(); asm volatile("" ::: "memory"); } while (0)
#define RESC(a) do { if (__any((a) < 1.f)) { if (hi == 0) al_l[r32] = (a); asm volatile("s_waitcnt lgkmcnt(0)" ::: "memory"); \
    _Pragma("unroll") for (int d = 0; d < 4; ++d) _Pragma("unroll") for (int r = 0; r < 16; ++r) o[d][r] *= al_l[crow(r, hi)]; } } while (0)
  const int vb0 = (int)(uintptr_t)(lds + RING_V) + v_rd_base(lane);
  f32x16 p0, p1; bf16x8 pa0, pa1, pa2, pa3;
  const int grp = wid >> 2;
#define BAR() do { asm volatile("" ::: "memory"); __builtin_amdgcn_s_barrier(); asm volatile("" ::: "memory"); } while (0)
#define VMW(n) asm volatile("s_waitcnt vmcnt(" #n ")" ::: "memory")
#define VPHASE() do { if (__builtin_expect(negBC != 0.f, 0)) { _Pragma("unroll") for (int r = 0; r < 16; ++r) { p0[r] += negBC; p1[r] += negBC; } } \
    _Pragma("unroll") for (int r = 0; r < 16; ++r) p0[r] = __builtin_amdgcn_exp2f(p0[r]); finishSM(p0, p1, 1.f, l_reg, pa0, pa1, pa2, pa3); } while (0)
#define MPHASE(t) do { __builtin_amdgcn_s_setprio(1); pv_pipe(o, VSLOT(t), pa0, pa1, pa2, pa3); if ((t) + 1 < NT) qkt8(p0, p1, KSLOT((t) + 1), q8, r32, hi); __builtin_amdgcn_s_setprio(0); } while (0)
  __syncthreads();
  DLOAD(0); DLOAD(1);
  { const int t = t0 + wid * QBLK + r32;
    q_prologue<true>(nullptr, q8, Qb + (size_t)(wid * QBLK + r32) * NQ + hi * 8, gain, hi, (float)(t >> 6), (float)(t & 63)); }
  VMW(3); BAR();
  if (grp == 0) {
    qkt8(p0, p1, KSLOT(0), q8, r32, hi);
#pragma unroll
    for (int r = 8; r < 16; ++r) p0[r] = NEG;
#pragma unroll
    for (int r = 0; r < 16; ++r) p1[r] = NEG;
    VMW(0); BAR();
    for (int t = 0; t < NT; ++t) {
      SBAR(); DLOAD(t + 2); SBAR();
      VPHASE();
      VMW(3); BAR();
      MPHASE(t);
      BAR();
    }
    BAR();
  } else {
    BAR();
    SBAR(); DLOAD(2); SBAR();
    qkt8(p0, p1, KSLOT(0), q8, r32, hi);
#pragma unroll
    for (int r = 8; r < 16; ++r) p0[r] = NEG;
#pragma unroll
    for (int r = 0; r < 16; ++r) p1[r] = NEG;
    VMW(3); BAR();
    for (int t = 0; t < NT; ++t) {
      SBAR(); DLOAD(t + 3); SBAR();
      VPHASE();
      BAR();
      MPHASE(t);
      VMW(3); BAR();
    }
  }
  asm volatile("s_waitcnt vmcnt(0)" ::: "memory");
  o_epilogue(o, l_reg, li_l, Ob + (size_t)(wid * QBLK) * NQ, Zb + (size_t)(wid * QBLK) * LD, r32, hi);
#undef BAR
#undef VMW
#undef VPHASE
#undef MPHASE
#undef DLOAD
#undef KSLOT
#undef VSLOT
#undef LANDED
}

__device__ __forceinline__ void na_item(const bf16_t* Qb, bf16_t* Ob, const bf16_t* __restrict__ Zb, const bf16_t* __restrict__ Kmeta, const bf16_t* __restrict__ Vmeta,
                                        const bf16_t* __restrict__ Kseq, const bf16_t* __restrict__ Vseq, int R0, int rows, const float* __restrict__ gain,
                                        const float* __restrict__ rpb_h, float negBC, char* lds, float* wsbase, LAS float* rpbs, int wid) {
  const int lane = lane_id_v(), tid = wid * 64 + lane, r32 = lane & 31, hi = lane >> 5;
  float* ws = wsbase + wid * 64; float* li_l = ws; float* al_l = ws + 32;
  float l_reg = 0; f32x16 o[4] = {}; bf16x8 qr[8];
  unsigned koff[2], voff[2];
#pragma unroll
  for (int i = 0; i < 2; ++i) { const int b = (wid * 2 + i) * 1024 + lane * 16;
    { const int row = b >> 8, cB = (b & 255) ^ ((row & 7) << 4); koff[i] = (unsigned)(row * LD * 2 + cB); }
    { const int sub = b >> 9, w = b & 511, kk = (sub >> 2) * 8 + (w >> 6), k = (kk & ~0xC) | ((kk & 4) << 1) | ((kk & 8) >> 1), c = (sub & 3) * 32 + ((w & 63) >> 1); voff[i] = (unsigned)(k * LD * 2 + c * 2); } }
  const int rmax = rows - 8;
  const int rlo = min(max(R0 - 4, 0), rmax), rhi = min(max(R0 - 1, 0), rmax) + 7, NT = 2 + rhi - rlo;
  const int rq = R0 + (wid >> 1), r0q = min(max(rq - 4, 0), rmax);
  const int par = wid & 1, cq = par * 32 + r32, c0 = min(max(cq - 8, 0), 48);
  LAS unsigned char* ldsl = (LAS unsigned char*)lds;
#define DLOAD(tt) do { const int _t = (tt) < NT ? (tt) : NT - 1; const int _s = (tt) & (NSLOT - 1); \
    const char* _k = (const char*)(_t == 0 ? Kmeta : Kseq + (size_t)(rlo + _t - 1) * 64 * LD); const char* _v = (const char*)(_t == 0 ? Vmeta : Vseq + (size_t)(rlo + _t - 1) * 64 * LD); \
    _Pragma("unroll") for (int _i = 0; _i < 2; ++_i) { \
      __builtin_amdgcn_global_load_lds((const unsigned*)(_k + koff[_i]), (LAS unsigned*)(ldsl + _s * SHM_K + (wid * 2 + _i) * 1024), 16, 0, 0); \
      __builtin_amdgcn_global_load_lds((const unsigned*)(_v + voff[_i]), (LAS unsigned*)(ldsl + RING_V + _s * SHM_V + (wid * 2 + _i) * 1024), 16, 0, 0); } } while (0)
#define LANDED() do { asm volatile("s_waitcnt vmcnt(4)" ::: "memory"); __builtin_amdgcn_s_barrier(); asm volatile("" ::: "memory"); } while (0)
  const int vb0 = (int)(uintptr_t)(lds + RING_V) + v_rd_base(lane);
  __syncthreads();
  for (int i = tid; i < 465; i += 512) rpbs[i] = rpb_h[i] * INV_SCALE;
  DLOAD(0); DLOAD(1);
  q_prologue<false>(qr, nullptr, Qb + (size_t)(wid * QBLK + r32) * NQ + hi * 8, gain, hi, 0.f, 0.f);
  asm volatile("s_waitcnt lgkmcnt(0)" ::: "memory");
  LANDED();
  for (int t = 0; t < NT; ++t) {
    SBAR(); DLOAD(t + 2); SBAR();
    const int rk = rlo + t - 1;
    if (t == 0 || (rk >= r0q && rk < r0q + 8)) {
      f32x16 p0, p1; bf16x8 pa0, pa1, pa2, pa3;
      { const int _ks = (int)(uintptr_t)lds + (t & (NSLOT - 1)) * SHM_K + r32 * 256, _sw = (r32 & 7) << 4;
        const int kb[4] = {_ks + ((0 + hi * 16) ^ _sw), _ks + ((32 + hi * 16) ^ _sw), _ks + ((64 + hi * 16) ^ _sw), _ks + ((96 + hi * 16) ^ _sw)};
        asm volatile("s_waitcnt lgkmcnt(0)" ::: "memory"); SBAR();
        qkt_pipe(p0, p1, kb, qr); }
      if (t == 0) {
#pragma unroll
        for (int r = 8; r < 16; ++r) p0[r] = NEG;
#pragma unroll
        for (int r = 0; r < 16; ++r) p1[r] = NEG;
      } else {
        const LAS float* brow = rpbs + (rk - rq + 7) * 31 + (15 - cq);
#define MB(P, r, ckb) do { const int ck = (ckb) + crow(r, hi); const bool v = (unsigned)(ck - c0) < 16u; const float b = brow[v ? ck : cq]; P[r] = v ? P[r] + b : NEG; } while (0)
        if (par == 0) {
#pragma unroll
          for (int r = 0; r < 16; ++r) MB(p0, r, 0);
#pragma unroll
          for (int r = 0; r < 4; ++r) MB(p1, r, 32);
#pragma unroll
          for (int r = 4; r < 16; ++r) p1[r] = NEG;
        } else {
#pragma unroll
          for (int r = 0; r < 12; ++r) p0[r] = NEG;
#pragma unroll
          for (int r = 12; r < 16; ++r) MB(p0, r, 0);
#pragma unroll
          for (int r = 0; r < 16; ++r) MB(p1, r, 32);
        }
#undef MB
      }
      partialSM_fix(p0, p1, negBC);
      finishSM(p0, p1, 1.f, l_reg, pa0, pa1, pa2, pa3);
      asm volatile("s_waitcnt lgkmcnt(0)" ::: "memory"); SBAR();
      pv_pipe(o, vb0 + (t & (NSLOT - 1)) * SHM_V, pa0, pa1, pa2, pa3);
    }
    LANDED();
  }
  asm volatile("s_waitcnt vmcnt(0)" ::: "memory");
  o_epilogue(o, l_reg, li_l, Ob + (size_t)(wid * QBLK) * NQ, Zb + (size_t)(wid * QBLK) * LD, r32, hi);
#undef DLOAD
#undef LANDED
#undef RESC
}
}


#define XB_TMO      128
#define XB_XCNT(j)  (256  + 64 * (j))
#define XB_XSUB(j)  (1280 + 64 * (j))
#define XB_XGEN(j)  (2304 + 64 * (j))
#define XB_TOP      3328
#define XB_TOPGEN   3392
#define XCD_BAR_WORDS 3456
#define XB_SPIN_CAP (1u << 18)
__device__ __forceinline__ unsigned xb_ld(unsigned* p)              { return __hip_atomic_load(p, __ATOMIC_RELAXED, __HIP_MEMORY_SCOPE_AGENT); }
__device__ __forceinline__ unsigned xb_add(unsigned* p, unsigned v) { return __hip_atomic_fetch_add(p, v, __ATOMIC_RELAXED, __HIP_MEMORY_SCOPE_AGENT); }
__device__ __forceinline__ unsigned xb_xcc_id() { return (unsigned)__builtin_amdgcn_s_getreg((3 << 11) | 20) & 0xFu; }
#define XB_SPIN(cond, bar) do { unsigned _sp = 0; while (cond) { __builtin_amdgcn_s_sleep(1); \
    if ((++_sp & 255u) == 0u) { if (xb_ld(&(bar)[XB_TMO])) break; if (_sp > XB_SPIN_CAP) { atomicAdd(&(bar)[XB_TMO], 1u); break; } } } } while (0)
struct XcdBarrier { unsigned* bar; unsigned x; volatile LAS unsigned* st; };
__device__ __forceinline__ void xcd_barrier_complete(unsigned* bar, unsigned x, unsigned& nloc, unsigned& nx) {
    const unsigned G = gridDim.x * gridDim.y * gridDim.z;
    unsigned sum, cnt, mine, sp = 0u;
    for (;;) {
        sum = 0u; cnt = 0u; mine = 0u;
#pragma unroll
        for (unsigned j = 0; j < 16; ++j) { const unsigned c = xb_ld(&bar[XB_XCNT(j)]); sum += c; cnt += (c > 0u) ? 1u : 0u; mine = (j == x) ? c : mine; }
        if (sum == G) break;
        __builtin_amdgcn_s_sleep(1);
        if ((++sp & 255u) == 0u) { if (xb_ld(&bar[XB_TMO])) break; if (sp > XB_SPIN_CAP) { atomicAdd(&bar[XB_TMO], 1u); break; } }
    }
    nloc = mine > 0u ? mine : 1u; nx = cnt > 0u ? cnt : 1u;
}
__device__ __forceinline__ void xcd_barrier(const XcdBarrier& b, bool t0) {
    asm volatile("s_waitcnt vmcnt(0)" ::: "memory");
    __syncthreads();
    if (t0) {
        unsigned* bar = b.bar;
        __builtin_amdgcn_s_waitcnt(0);
        unsigned nloc = b.st[0], nx = b.st[1];
        if (nloc == 0u) { xcd_barrier_complete(bar, b.x, nloc, nx); b.st[0] = nloc; b.st[1] = nx; }
        const unsigned old = xb_add(&bar[XB_XSUB(b.x)], 1u);
        const unsigned gen = old / nloc;
        if (old + 1u == (gen + 1u) * nloc) {
            __builtin_amdgcn_fence(__ATOMIC_RELEASE, "agent");
            asm volatile("s_waitcnt vmcnt(0)" ::: "memory");
            const unsigned og = xb_add(&bar[XB_TOP], 1u);
            const unsigned tg = og / nx;
            if (og + 1u == (tg + 1u) * nx) xb_add(&bar[XB_TOPGEN], 1u);
            else XB_SPIN(xb_ld(&bar[XB_TOPGEN]) == tg, bar);
            __builtin_amdgcn_fence(__ATOMIC_ACQUIRE, "agent");
            xb_add(&bar[XB_XGEN(b.x)], 1u);
            asm volatile("s_waitcnt vmcnt(0)" ::: "memory");
        } else {
            XB_SPIN(xb_ld(&bar[XB_XGEN(b.x)]) == gen, bar);
            __builtin_amdgcn_fence(__ATOMIC_ACQUIRE, "agent");
            asm volatile("s_waitcnt vmcnt(0)" ::: "memory");
        }
    }
    __syncthreads();
}

__device__ __forceinline__ void transpose_item(const float* __restrict__ W, int K, int N, bf16_t* __restrict__ WT, unsigned char* __restrict__ WT8, int k0, int n0, int dst_n0, int sig, LAS float* scr, int lane) {
    float t[32];
#pragma unroll
    for (int i = 0; i < 32; ++i) t[i] = __builtin_nontemporal_load(&W[(size_t)(k0 + 2 * i + (lane >> 5)) * N + n0 + (lane & 31)]);
#pragma unroll
    for (int i = 0; i < 32; ++i) scr[(2 * i + (lane >> 5)) * 33 + (lane & 31)] = t[i];
    asm volatile("s_waitcnt lgkmcnt(0)" ::: "memory");
    const int c = lane & 7;
#pragma unroll
    for (int j = 0; j < 4; ++j) { const int n = (lane >> 3) + 8 * j; const LAS float* sp = scr + (8 * c) * 33 + n;
        const int drow = sig < 0 ? dst_n0 + n : dst_n0 + 64 * (sig >> 6) + 4 * ((sig >> 5) & 1) + 32 * (n >> 4) + 8 * ((n >> 2) & 3) + (n & 3);
        u32x4 o; o.x = cvtpk(sp[0 * 33], sp[1 * 33]); o.y = cvtpk(sp[2 * 33], sp[3 * 33]); o.z = cvtpk(sp[4 * 33], sp[5 * 33]); o.w = cvtpk(sp[6 * 33], sp[7 * 33]);
        if (!(WT8 && drow < 3584 && (drow < 1024 || drow >= 2048))) *(u32x4*)(WT + (size_t)drow * K + k0 + 8 * c) = o;
        if (WT8) { u32x2 o8; o8.x = pk4_fp8(sp[0 * 33] * 64.f, sp[1 * 33] * 64.f, sp[2 * 33] * 64.f, sp[3 * 33] * 64.f); o8.y = pk4_fp8(sp[4 * 33] * 64.f, sp[5 * 33] * 64.f, sp[6 * 33] * 64.f, sp[7 * 33] * 64.f);
            *(u32x2*)(WT8 + (size_t)drow * K + k0 + 8 * c) = o8; } }
    asm volatile("s_waitcnt lgkmcnt(0)" ::: "memory");
}
__device__ __forceinline__ int remap_in_col(int n0) {
    if (n0 < 1024) return n0;
    if (n0 < 1280) return 2048 + (n0 - 1024);
    if (n0 < 1536) return 2304 + (n0 - 1280);
    if (n0 < 2560) return 2560 + (n0 - 1536);
    if (n0 < 3584) return 1024 + (n0 - 2560);
    return n0;
}

struct Args { const float* x_prompt; const float* x_sample; const float* meta; const float* norm_w; const float* w_in; const float* qna; const float* kna; const float* qnb; const float* knb;
              const float* rpb; const float* w_out; float* out; unsigned char* ws; int ph_lo, ph_hi; };

__global__ void __launch_bounds__(NWAVES * 64, 2) hymba_fwd(Args a) {
    extern __shared__ __attribute__((aligned(16))) unsigned char lds[];
    const int wave = __builtin_amdgcn_readfirstlane(threadIdx.x >> 6);
    const int G = gridDim.x, bx = blockIdx.x;
    const int lo = a.ph_lo, hi_ph = a.ph_hi;
    bf16_t* Qbuf = (bf16_t*)(a.ws + WS_Q); bf16_t* U = (bf16_t*)(a.ws + WS_U); bf16_t* WoutT = (bf16_t*)(a.ws + WS_WOUT);
    bf16_t* XN = (bf16_t*)((unsigned char*)a.out + OUT_XN); bf16_t* WinT = (bf16_t*)((unsigned char*)a.out + OUT_WIN);
#define IN(k) ((((PH_MASK) >> (k)) & 1) && lo <= (k) && (k) < hi_ph)
    volatile LAS unsigned* bst = (volatile LAS unsigned*)((LAS unsigned char*)lds + MISC_OFF + 4096);
    const bool t0 = (wave == 0) && (lane_id_v() == 0);
    XcdBarrier bar; bar.bar = (unsigned*)(a.ws + WS_BAR); bar.x = xb_xcc_id(); bar.st = bst;
    if (hi_ph - lo > 1) { if (t0) { bst[0] = 0u; bst[1] = 0u; (void)xb_add(&bar.bar[XB_XCNT(bar.x)], 1u); } __syncthreads(); }
    if (lo < 0) cg::this_grid().sync();
#define SEAM(k) do { if (IN(k) && IN((k) + 1)) xcd_barrier(bar, (wave == 0) && (lane_id_v() == 0)); } while (0)

    for (int rep = 0; rep < 1 + ((DUP_MASK >> 0) & 1); ++rep)
    if (IN(0)) {
        const int lane = lane_id_v();
        LAS float* scr = (LAS float*)((LAS unsigned char*)lds + wave * 16384);
        const int gw = bx * NWAVES + wave, NGW = G * NWAVES;
        constexpr int I_IN = (DM / 64) * (NIN / 32);
        for (int it = gw; it < I_IN; it += NGW) {
            const int nblk = NIN / 32, kb = it / nblk, nb = it % nblk; const int n0 = 32 * nb; const bool rope = n0 < 1280;
            transpose_item(a.w_in, DM, NIN, WinT, a.ws + WS_WIN8, 64 * kb, n0, rope ? remap_in_col(n0 & ~127) : remap_in_col(n0), rope ? (n0 & 127) : -1, scr, lane);
        }
        for (int m0 = gw; m0 < MROWS; m0 += 2 * NGW) {
            f32x4 v[2][8]; float s[2] = {0.f, 0.f};
#pragma unroll
            for (int u = 0; u < 2; ++u) { const int m = m0 + u * NGW;
                if (m < META_ROW0 + 16) {
                    const float* xrow = m < 8192 ? a.x_prompt + (size_t)m * DM : (m < NTOK ? a.x_sample + (size_t)(m - 8192) * DM : a.meta + (size_t)(m - META_ROW0) * DM);
                    const f32x4* xr = (const f32x4*)xrow + lane;
#pragma unroll
                    for (int j = 0; j < 8; ++j) v[u][j] = __builtin_nontemporal_load(&xr[64 * j]);
                } else {
#pragma unroll
                    for (int j = 0; j < 8; ++j) v[u][j] = (f32x4){0.f, 0.f, 0.f, 0.f};
                } }
#pragma unroll
            for (int u = 0; u < 2; ++u)
#pragma unroll
                for (int j = 0; j < 8; ++j) s[u] += (v[u][j].x * v[u][j].x + v[u][j].y * v[u][j].y) + (v[u][j].z * v[u][j].z + v[u][j].w * v[u][j].w);
#pragma unroll
            for (int o = 1; o < 64; o <<= 1) { s[0] += __shfl_xor(s[0], o); s[1] += __shfl_xor(s[1], o); }
            const f32x4* gw4 = (const f32x4*)a.norm_w + lane;
#pragma unroll
            for (int u = 0; u < 2; ++u) { const int m = m0 + u * NGW; if (m >= MROWS) continue;
                const float rs = __builtin_amdgcn_rsqf(s[u] * (1.f / DM) + EPS);
                unsigned long long* o8 = (unsigned long long*)(XN + (size_t)m * DM) + lane; unsigned* o4 = (unsigned*)((unsigned char*)a.out + OUT_XN8 + (size_t)m * DM) + lane;
#pragma unroll
                for (int j = 0; j < 8; ++j) { const f32x4 g = gw4[64 * j]; const float y0 = v[u][j].x * rs * g.x, y1 = v[u][j].y * rs * g.y, y2 = v[u][j].z * rs * g.z, y3 = v[u][j].w * rs * g.w;
                    o8[64 * j] = (unsigned long long)cvtpk(y0, y1) | ((unsigned long long)cvtpk(y2, y3) << 32); o4[64 * j] = pk4_fp8(y0, y1, y2, y3); } }
        }
    }
    SEAM(0);

    for (int rep = 0; rep < 1 + ((DUP_MASK >> 1) & 1); ++rep)
    if (IN(1)) {
        pg8::EpiU E{Qbuf, U, a.ws + WS_KF8, a.kna, a.knb, (LAS float*)((LAS unsigned char*)lds + MISC_OFF + 8192)};
        { pg8::Gemm g{XN, WinT, DM * 2, DM * 2, DM / 64}; pg8::Order S; S.init(NTOK / 256, 16, G, bx, 0, 1);
          f32x4 acc1[2][2][4][2]; pg8::gemm_phase<pg8::EpiU, pg8::Order, true, true, false>((LAS unsigned char*)lds, g, S, E, wave, acc1, false); }
        { pg8::Gemm g{(unsigned char*)a.out + OUT_XN8, a.ws + WS_WIN8, DM, DM, DM / 128}; pg8::Order S; S.init(NTOK / 256, 10, G, bx, 10, 2);
          f32x4 acc1[2][2][4][2]; pg8::gemm_phase<pg8::EpiU, pg8::Order, true, true, true>((LAS unsigned char*)lds, g, S, E, wave, acc1, false); }
        { constexpr int FIRST = (64 * 10 + 10) - 2 * 256; const int nidle = G - FIRST;
          if (G == 256 ? bx >= FIRST : true) { const int lane = lane_id_v(); LAS float* scr = (LAS float*)((LAS unsigned char*)lds + wave * 16384);
            const int gw = (G == 256 ? bx - FIRST : bx) * NWAVES + wave, NGW = (G == 256 ? nidle : G) * NWAVES; constexpr int I_OUT = (DM / 64) * (DM / 32);
            for (int it = gw; it < I_OUT; it += NGW) { const int nblk = DM / 32, kb = it / nblk, nb = it % nblk; transpose_item(a.w_out, DM, DM, WoutT, nullptr, 64 * kb, 32 * nb, 32 * nb, -1, scr, lane); } } }
    }
    float negBC_a = 0.f, negBC_b = 0.f;
    if (IN(2)) {
        { const int ln = lane_id_v(); float gq = fmaxf(fabsf(a.qna[ln]), fabsf(a.qna[ln + 64])), gk = fmaxf(fabsf(a.kna[ln]), fabsf(a.kna[ln + 64]));
#pragma unroll
          for (int o = 1; o < 64; o <<= 1) { gq = fmaxf(gq, __shfl_xor(gq, o)); gk = fmaxf(gk, __shfl_xor(gk, o)); }
          negBC_a = fminf(0.f, 60.f - 11.313708498984761f * gq * gk * 1.4426950408889634f); }
        { const int ln = lane_id_v(); float gq = fmaxf(fabsf(a.qnb[ln]), fabsf(a.qnb[ln + 64])), gk = fmaxf(fabsf(a.knb[ln]), fabsf(a.knb[ln + 64])), bm = 0.f;
          for (int i = ln; i < 8 * 465; i += 64) bm = fmaxf(bm, fabsf(a.rpb[i]));
#pragma unroll
          for (int o = 1; o < 64; o <<= 1) { gq = fmaxf(gq, __shfl_xor(gq, o)); gk = fmaxf(gk, __shfl_xor(gk, o)); bm = fmaxf(bm, __shfl_xor(bm, o)); }
          negBC_b = -(11.313708498984761f * gq * gk + bm) * 1.4426950408889634f; }
    }
    SEAM(1);

    if (IN(2)) {
        const bf16_t* Umeta = U + (size_t)META_ROW0 * NU; const unsigned char* Kf8 = a.ws + WS_KF8;
#ifndef NO_ATT_A
        for (int rep = 0; rep < 1 + ((DUP_MASK >> 5) & 1); ++rep)
        for (int it = bx; it < 512; it += G) {
            const int h = it & 7, r = (it & 255) >> 3; int base, S, qb;
            if (it < 256) { base = 0; S = 8192; qb = r; } else { base = 8192 + (r >> 3) * 2048; S = 2048; qb = r & 7; }
            const int g = h >> 2;
            bf16_t* Qb = Qbuf + (size_t)(base + qb * 256) * NQ + C_QA + h * 128;
            const bf16_t* Zb = U + (size_t)(base + qb * 256) * NU + C_ZA + h * 128;
            att::attnA_item(Qb, (DUP_MASK & 32) && rep == 0 ? (bf16_t*)a.out : Qb, Zb, Kf8 + (size_t)META_ROW0 * 256 + g * 128, Umeta + C_VA + g * 128, Kf8 + (size_t)base * 256 + g * 128, U + (size_t)base * NU + C_VA + g * 128,
                            S, qb * 256, a.qna, negBC_a, (char*)lds, (float*)((char*)lds + MISC_OFF + 2048), wave);
        }
#endif
#ifndef NO_ATT_NA
        unsigned* na_ctr = (unsigned*)(a.ws + WS_BAR) + 3520; volatile LAS int* qslot = (volatile LAS int*)((LAS unsigned char*)lds + MISC_OFF + 4096 + 32);
        for (;;) {
            __syncthreads();
            if (wave == 0 && lane_id_v() == 0) *qslot = (int)__hip_atomic_fetch_add(na_ctr, 1u, __ATOMIC_RELAXED, __HIP_MEMORY_SCOPE_AGENT);
            __syncthreads();
            const int it = __builtin_amdgcn_readfirstlane(*qslot);
            if (it >= 512) break;
            const int rep = 1;
            const int h = it & 7, tb = it >> 3; int base, rows, lb;
            if (tb < 32) { base = 0; rows = 128; lb = tb; } else { base = 8192 + ((tb - 32) >> 3) * 2048; rows = 32; lb = (tb - 32) & 7; }
            bf16_t* Qb = Qbuf + (size_t)(base + lb * 256) * NQ + C_QB + h * 128;
            const bf16_t* Zb = U + (size_t)(base + lb * 256) * NU + C_ZB + h * 128;
            att::na_item(Qb, (DUP_MASK & 64) && rep == 0 ? (bf16_t*)a.out : Qb, Zb, Umeta + C_KB + h * 128, Umeta + C_VB + h * 128, U + (size_t)base * NU + C_KB + h * 128, U + (size_t)base * NU + C_VB + h * 128,
                         lb * 4, rows, a.qnb, a.rpb + h * 465, negBC_b, (char*)lds, (float*)((char*)lds + MISC_OFF + 2048), (LAS float*)((LAS unsigned char*)lds + MISC_OFF), wave);
        }
#endif
    }
    f32x4 acc3[2][2][4][2]; bool pre3 = false;
    if (IN(2) && IN(3)) { pg8::Order S3; S3.init(NTOK / 256, DM / 256, G, bx, 0); pg8::Unit u0;
        if (S3.next(0, u0)) { const int ln = lane_id_v(); pg8::EpiOut E3{a.x_prompt, a.x_sample, a.out}; E3.init(acc3, u0, wave >> 2, wave & 3, ln & 15, ln >> 4); pre3 = true; } }
    SEAM(2);

    for (int rep = 0; rep < 1 + ((DUP_MASK >> 4) & 1); ++rep)
    if (IN(3)) {
        __syncthreads();
        pg8::Gemm g{Qbuf, WoutT, NQ * 2, DM * 2, DM / 64}; pg8::Order S; S.init(NTOK / 256, DM / 256, G, bx, 0);
        pg8::EpiOut E{a.x_prompt, a.x_sample, a.out};
        pg8::gemm_phase<pg8::EpiOut, pg8::Order, true, true>((LAS unsigned char*)lds, g, S, E, wave, acc3, pre3 && rep == 0);
    }
#undef IN
#undef SEAM
}

extern "C" void kernel_launch(void* const* d_in, const int* in_sizes, int n_in, void* d_out, int out_size, void* d_ws, size_t ws_size, hipStream_t stream) {
    static int grid = 0;
    if (grid == 0) {
        if (n_in != 11 || out_size != NTOK * DM || ws_size < WS_END) { fprintf(stderr, "kernel_launch: unexpected shapes (n_in %d out %d ws %zu)\n", n_in, out_size, ws_size); grid = -1; return; }
        int dev = 0, cus = 0, per_cu = 0;
        if (hipGetDevice(&dev) != hipSuccess || hipDeviceGetAttribute(&cus, hipDeviceAttributeMultiprocessorCount, dev) != hipSuccess) { grid = -1; return; }
        if (hipFuncSetAttribute((const void*)hymba_fwd, hipFuncAttributeMaxDynamicSharedMemorySize, LDS_BYTES) != hipSuccess) { fprintf(stderr, "kernel_launch: hipFuncSetAttribute failed\n"); grid = -1; return; }
        if (hipOccupancyMaxActiveBlocksPerMultiprocessor(&per_cu, (const void*)hymba_fwd, NWAVES * 64, LDS_BYTES) != hipSuccess || per_cu < 1) { fprintf(stderr, "kernel_launch: occupancy query says %d\n", per_cu); per_cu = 1; }
        (void)hipGetLastError();
        grid = cus * per_cu;
    }
    if (grid < 0) return;
    if (MK_COOP && hipMemsetAsync((char*)d_ws + WS_BAR, 0, WS_BAR_BYTES, stream) != hipSuccess) { fprintf(stderr, "kernel_launch: memset failed\n"); return; }
    Args a{};
    a.x_prompt = (const float*)d_in[0]; a.x_sample = (const float*)d_in[1]; a.meta = (const float*)d_in[2]; a.norm_w = (const float*)d_in[3]; a.w_in = (const float*)d_in[4];
    a.qna = (const float*)d_in[5]; a.kna = (const float*)d_in[6]; a.qnb = (const float*)d_in[7]; a.knb = (const float*)d_in[8]; a.rpb = (const float*)d_in[9]; a.w_out = (const float*)d_in[10];
    a.out = (float*)d_out; a.ws = (unsigned char*)d_ws;
#if MK_COOP
    a.ph_lo = 0; a.ph_hi = 4;
    void* args[] = {&a};
    hipError_t e = hipLaunchCooperativeKernel((const void*)hymba_fwd, dim3(grid), dim3(NWAVES * 64), args, LDS_BYTES, stream);
    if (e != hipSuccess) fprintf(stderr, "kernel_launch: cooperative launch failed: %s (grid %d)\n", hipGetErrorString(e), grid);
#else
    for (int ph = 0; ph < 4; ++ph) {
        a.ph_lo = ph; a.ph_hi = ph + 1;
        hipLaunchKernelGGL(hymba_fwd, dim3(grid), dim3(NWAVES * 64), LDS_BYTES, stream, a);
    }
    const hipError_t le = hipPeekAtLastError();
    if (le != hipSuccess) fprintf(stderr, "kernel_launch: launch failed: %s\n", hipGetErrorName(le));
#endif
}
```
